# Optimizing an MI355X kernel written in HIP

```python
import jax, jax.numpy as jnp
from jax import lax
import numpy as np

D_MODEL = 2048
BATCH = 8
SEQ = 4096
DEPTH = 4

GRID_W = 64
CTX_LEN = 256
Q_BLOCK = 128
ROPE_THETA = 10000.0
EPS = 1e-6
A_HEADS = 8
A_KV_HEADS = 2
A_GROUP = A_HEADS // A_KV_HEADS
A_HEAD_DIM = 128
B_HEADS = 8
B_Q_RANK = 512
B_KV_RANK = 256
B_NOPE_DIM = 128
B_ROPE_DIM = 64
B_V_DIM = 128
A_SCALE = A_HEAD_DIM ** -0.5
B_SCALE = (B_NOPE_DIM + B_ROPE_DIM) ** -0.5
ATTN_SIZES = (A_HEADS * A_HEAD_DIM, A_KV_HEADS * A_HEAD_DIM, A_KV_HEADS * A_HEAD_DIM,
              B_Q_RANK, B_KV_RANK, B_ROPE_DIM)
ATTN_IN = sum(ATTN_SIZES)
ATTN_OUT = A_HEADS * A_HEAD_DIM + B_HEADS * B_V_DIM
SC_WIDTH = D_MODEL
CONV_W = 3
D_FF = 256 * ((8 * D_MODEL // 3 + 255) // 256)
N_ATTN_LAYERS = (DEPTH + 1) // 2
N_CONV_LAYERS = DEPTH // 2

kernel_name = "hybrid_dit_gqa_mla_shortconv_convffn"


def rms_norm(x, w):
    xf = x.astype(jnp.float32)
    y = xf * lax.rsqrt(jnp.mean(xf * xf, axis=-1, keepdims=True) + EPS)
    return (y * w.astype(jnp.float32)).astype(x.dtype)


def adaln(cvec, w, b):
    m = jax.nn.silu(cvec) @ w + b
    if m.ndim == 2:
        m = m[:, None, :]
    return jnp.split(m, 6, axis=-1)


def modulate(h, shift, scale):
    return h * (1.0 + scale) + shift


def axial_rope_tables(rows, rot_dim, dtype):
    r = jnp.repeat(jnp.arange(rows, dtype=jnp.float32), GRID_W)
    col = jnp.tile(jnp.arange(GRID_W, dtype=jnp.float32), rows)
    quarter = rot_dim // 4
    inv = ROPE_THETA ** (-jnp.arange(quarter, dtype=jnp.float32) / quarter)
    ar = r[:, None] * inv
    ac = col[:, None] * inv
    ang = jnp.concatenate([ar, ar, ac, ac], axis=-1)
    return jnp.cos(ang).astype(dtype), jnp.sin(ang).astype(dtype)


def apply_rope(x, cos, sin):
    shape = (cos.shape[0],) + (1,) * (x.ndim - 3) + (cos.shape[-1],)
    cos = cos.reshape(shape)
    sin = sin.reshape(shape)
    a, b, c, d = jnp.split(x, 4, axis=-1)
    rot = jnp.concatenate([-b, a, -d, c], axis=-1)
    return x * cos + rot * sin


def dwconv(x, w):
    s = x.shape[1]
    pad = CONV_W // 2
    xp = jnp.pad(x, ((0, 0), (pad, CONV_W - 1 - pad), (0, 0)))
    out = xp[:, 0:s] * w[0]
    for j in range(1, CONV_W):
        out = out + xp[:, j:j + s] * w[j]
    return out


def blocked_attention(q, k, v, scale):
    bn, s, kh, g, dq = q.shape
    nb = s // Q_BLOCK
    qb = q.reshape(bn, nb, Q_BLOCK, kh, g, dq).transpose(1, 0, 2, 3, 4, 5)

    def one_block(qblk):
        sc = jnp.einsum('bqhgd,bthd->bhgqt', qblk, k,
                        preferred_element_type=jnp.float32) * scale
        p = jax.nn.softmax(sc, axis=-1).astype(v.dtype)
        return jnp.einsum('bhgqt,bthd->bqhgd', p, v)

    o = lax.map(one_block, qb)
    return o.transpose(1, 0, 2, 3, 4, 5).reshape(bn, s, kh * g * v.shape[-1])


def attn_project(h, w_in, q_norm_a, k_norm_a, q_norm_b, kv_norm_b, w_uq, w_ukv,
                 rope_a, rope_b, with_queries):
    bn, s, _ = h.shape
    proj = h @ w_in
    idx, acc = [], 0
    for sz in ATTN_SIZES[:-1]:
        acc += sz
        idx.append(acc)
    qa, ka, va, cq, ckv, kr = jnp.split(proj, idx, axis=-1)
    ka = rms_norm(ka.reshape(bn, s, A_KV_HEADS, A_HEAD_DIM), k_norm_a)
    va = va.reshape(bn, s, A_KV_HEADS, A_HEAD_DIM)
    kv = (rms_norm(ckv, kv_norm_b) @ w_ukv).reshape(bn, s, B_HEADS, B_NOPE_DIM + B_V_DIM)
    k_nope, vb = jnp.split(kv, [B_NOPE_DIM], axis=-1)
    if rope_a is not None:
        ka = apply_rope(ka, *rope_a)
        kr = apply_rope(kr, *rope_b)
    kb = jnp.concatenate(
        [k_nope, jnp.broadcast_to(kr[:, :, None, :], (bn, s, B_HEADS, B_ROPE_DIM))], axis=-1)
    if not with_queries:
        return None, ka, va, None, kb, vb
    qa = rms_norm(qa.reshape(bn, s, A_KV_HEADS, A_GROUP, A_HEAD_DIM), q_norm_a)
    qb = (rms_norm(cq, q_norm_b) @ w_uq).reshape(bn, s, B_HEADS, B_NOPE_DIM + B_ROPE_DIM)
    q_nope, q_rope = jnp.split(qb, [B_NOPE_DIM], axis=-1)
    if rope_a is not None:
        qa = apply_rope(qa, *rope_a)
        q_rope = apply_rope(q_rope, *rope_b)
    qb = jnp.concatenate([q_nope, q_rope], axis=-1)[:, :, :, None, :]
    return qa, ka, va, qb, kb, vb


def short_conv_mixer(h, w_in, conv_w, w_out):
    b, cg, v = jnp.split(h @ w_in, 3, axis=-1)
    return (b * dwconv(cg * v, conv_w)) @ w_out


def conv_ffn(h, w_up, conv_w, w_down):
    g, u = jnp.split(dwconv(h @ w_up, conv_w), 2, axis=-1)
    return (jax.nn.silu(g) * u) @ w_down


def setup_inputs(seed: int = 0) -> dict:
    key = jax.random.key(seed)
    ks = jax.random.split(key, 23)
    f32 = jnp.float32

    def nrm(k, shape, scale):
        return jax.random.normal(k, shape, f32) * scale

    def gain(k, shape):
        return 1.0 + 0.02 * jax.random.normal(k, shape, f32)

    D = D_MODEL
    return {
        "x": nrm(ks[0], (BATCH, SEQ, D), 1.0),
        "c": nrm(ks[1], (BATCH, D), 1.0),
        "ctx": nrm(ks[2], (BATCH, CTX_LEN, D), 1.0),
        "c_ctx": nrm(ks[3], (D,), 1.0),
        "w_ada": nrm(ks[4], (DEPTH, D, 6 * D), 0.5 * D ** -0.5),
        "b_ada": nrm(ks[5], (DEPTH, 6 * D), 0.02),
        "norm_mix": gain(ks[6], (DEPTH, D)),
        "norm_ffn": gain(ks[7], (DEPTH, D)),
        "attn_w_in": nrm(ks[8], (N_ATTN_LAYERS, D, ATTN_IN), D ** -0.5),
        "attn_q_norm": gain(ks[9], (N_ATTN_LAYERS, A_HEAD_DIM)),
        "attn_k_norm": gain(ks[10], (N_ATTN_LAYERS, A_HEAD_DIM)),
        "mla_q_norm": gain(ks[11], (N_ATTN_LAYERS, B_Q_RANK)),
        "mla_kv_norm": gain(ks[12], (N_ATTN_LAYERS, B_KV_RANK)),
        "mla_w_uq": nrm(ks[13], (N_ATTN_LAYERS, B_Q_RANK, B_HEADS * (B_NOPE_DIM + B_ROPE_DIM)),
                        B_Q_RANK ** -0.5),
        "mla_w_ukv": nrm(ks[14], (N_ATTN_LAYERS, B_KV_RANK, B_HEADS * (B_NOPE_DIM + B_V_DIM)),
                         B_KV_RANK ** -0.5),
        "attn_w_o": nrm(ks[15], (N_ATTN_LAYERS, ATTN_OUT, D), ATTN_OUT ** -0.5),
        "sc_w_in": nrm(ks[16], (N_CONV_LAYERS, D, 3 * SC_WIDTH), D ** -0.5),
        "sc_conv": nrm(ks[17], (N_CONV_LAYERS, CONV_W, SC_WIDTH), CONV_W ** -0.5),
        "sc_w_out": nrm(ks[18], (N_CONV_LAYERS, SC_WIDTH, D), SC_WIDTH ** -0.5),
        "ffn_w_up": nrm(ks[19], (DEPTH, D, 2 * D_FF), D ** -0.5),
        "ffn_conv": nrm(ks[20], (DEPTH, CONV_W, 2 * D_FF), CONV_W ** -0.5),
        "ffn_w_down": nrm(ks[21], (DEPTH, D_FF, D), D_FF ** -0.5),
        "final_norm": gain(ks[22], (D,)),
    }


def reference(x, c, ctx, c_ctx, w_ada, b_ada, norm_mix, norm_ffn, attn_w_in, attn_q_norm,
              attn_k_norm, mla_q_norm, mla_kv_norm, mla_w_uq, mla_w_ukv, attn_w_o,
              sc_w_in, sc_conv, sc_w_out, ffn_w_up, ffn_conv, ffn_w_down, final_norm):
    ROWS = x.shape[1] // GRID_W
    rope_a = axial_rope_tables(ROWS, A_HEAD_DIM, x.dtype)
    rope_b = axial_rope_tables(ROWS, B_ROPE_DIM, x.dtype)
    xc = ctx
    for l in range(DEPTH):
        later_attn = any(j % 2 == 0 for j in range(l + 1, DEPTH))
        is_attn = (l % 2 == 0)
        sh, sc, g, shf, scf, gf = adaln(c, w_ada[l], b_ada[l])
        h = modulate(rms_norm(x, norm_mix[l]), sh, sc)
        if is_attn or later_attn:
            csh, csc, cg, cshf, cscf, cgf = adaln(c_ctx, w_ada[l], b_ada[l])
            hc = modulate(rms_norm(xc, norm_mix[l]), csh, csc)
        if is_attn:
            i = l // 2
            prm = (attn_w_in[i], attn_q_norm[i], attn_k_norm[i], mla_q_norm[i], mla_kv_norm[i],
                   mla_w_uq[i], mla_w_ukv[i])
            qa_c, ka_c, va_c, qb_c, kb_c, vb_c = attn_project(hc, *prm, None, None, later_attn)
            qa_l, ka_l, va_l, qb_l, kb_l, vb_l = attn_project(h, *prm, rope_a, rope_b, True)
            ka_all = jnp.concatenate([ka_c, ka_l], axis=1)
            va_all = jnp.concatenate([va_c, va_l], axis=1)
            kb_all = jnp.concatenate([kb_c, kb_l], axis=1)
            vb_all = jnp.concatenate([vb_c, vb_l], axis=1)
            y = jnp.concatenate([blocked_attention(qa_l, ka_all, va_all, A_SCALE),
                                 blocked_attention(qb_l, kb_all, vb_all, B_SCALE)],
                                axis=-1) @ attn_w_o[i]
            if later_attn:
                yc = jnp.concatenate([blocked_attention(qa_c, ka_c, va_c, A_SCALE),
                                      blocked_attention(qb_c, kb_c, vb_c, B_SCALE)],
                                     axis=-1) @ attn_w_o[i]
        else:
            i = l // 2
            y = short_conv_mixer(h, sc_w_in[i], sc_conv[i], sc_w_out[i])
            if later_attn:
                yc = short_conv_mixer(hc, sc_w_in[i], sc_conv[i], sc_w_out[i])
        x = x + g * y
        hf = modulate(rms_norm(x, norm_ffn[l]), shf, scf)
        x = x + gf * conv_ffn(hf, ffn_w_up[l], ffn_conv[l], ffn_w_down[l])
        if later_attn:
            xc = xc + cg * yc
            hcf = modulate(rms_norm(xc, norm_ffn[l]), cshf, cscf)
            xc = xc + cgf * conv_ffn(hcf, ffn_w_up[l], ffn_conv[l], ffn_w_down[l])
    return rms_norm(x, final_norm)
```

```cpp
#include <hip/hip_runtime.h>
#include <hip/hip_bf16.h>
#include <cstdio>
#include <cstdint>
namespace pg8 {
#define PG8_LAS __attribute__((address_space(3)))
typedef unsigned short bf16_t;
typedef short bf16x8 __attribute__((ext_vector_type(8)));
typedef float f32x4 __attribute__((ext_vector_type(4)));
typedef unsigned u32x4 __attribute__((ext_vector_type(4)));
typedef unsigned u32x2 __attribute__((ext_vector_type(2)));
constexpr int NSBT_IN = 10, NSBT_SC = 24, NSBT_UP = 44;
constexpr int BM = 256, BK = 64, HALF = 128, HTB = HALF * BK * 2  , STAGE_BYTES = 8 * HTB, NXCD = 8, WGM = 8;

__host__ __device__ __forceinline__ int lds_byte(int r, int c) { const int st = (r >> 4) * 2 + (c >> 5), rr = r & 15, cc = c & 31, ob = rr * 64 + cc * 2; return st * 1024 + (ob ^ (((ob >> 9) & 1) << 5)); }
__host__ __device__ __forceinline__ void stage_rc(int b, int& R, int& C) { const int st = b / 1024, sb = b % 1024, swz = sb ^ (((sb >> 9) & 1) << 5); R = (st >> 1) * 16 + swz / 64; C = (st & 1) * 32 + (swz % 64) / 2; }
__host__ __device__ __forceinline__ int perm32(int rho) { const int n = rho >> 4, i = rho & 15; return 8 * (i >> 2) + 4 * n + (i & 3); }

__device__ __forceinline__ int lane_id_l() { int l = (int)__builtin_amdgcn_mbcnt_hi(~0u, __builtin_amdgcn_mbcnt_lo(~0u, 0u)); asm volatile("" : "+v"(l)); return l; }
struct Unit { int pm, pn, kb, nt; };
struct Gemm { const bf16_t* A; const bf16_t* Bt; int M, N, K; };

struct StaticOrder {
    static constexpr bool SPLIT = false;
    int nM, nN, nwg, G, c;
    __host__ __device__ void init(int M, int N, int G_, int c_) { nM = M / BM; nN = N / BM; nwg = nM * nN; G = G_; c = c_; }
    __host__ __device__ bool next(int i, Unit& u) const {
        const long L = (long)i * G + c; if (L >= nwg) return false;
        int wgid = (int)L; { const int q = nwg / NXCD, r = nwg % NXCD, xcd = wgid % NXCD, off = wgid / NXCD; wgid = (xcd < r ? xcd * (q + 1) : r * (q + 1) + (xcd - r) * q) + off; }
        const int nig = WGM * nN, gid = wgid / nig, fm = gid * WGM, gsz = (nM - fm) < WGM ? (nM - fm) : WGM;
        u.pm = fm + ((wgid % nig) % gsz); u.pn = (wgid % nig) / gsz; u.kb = 0; u.nt = 0; return true;
    }
    __device__ __forceinline__ void a_ready(const Unit&) const {}
    __device__ __forceinline__ void done(const Unit&) const {}
};

__device__ __forceinline__ unsigned cvt_pk_bf16(float lo, float hi) { unsigned r; asm volatile("v_cvt_pk_bf16_f32 %0, %1, %2" : "=v"(r) : "v"(lo), "v"(hi)); return r; }
typedef float f32x2 __attribute__((ext_vector_type(2)));

constexpr int SB_LD = 62464;
template <int LDC> struct EpiStoreBf16 {
    static constexpr bool PREF = false, PERM = true, AFTER_DRAIN = false, APERM = false; static constexpr int ldc = LDC;
    bf16_t* O;
    __device__ __forceinline__ void operator()(const f32x4 (&acc)[2][2][4][2], const Unit& u, int wr, int wc, int fr, int fq) const {
        { const int t_ = lane_id_l(); fr = t_ & 15; fq = t_ >> 4; }
        const int row0 = u.pm * BM + wr * 64 + fr, col0 = u.pn * BM + wc * 32 + 8 * fq;
#pragma unroll
        for (int ai = 0; ai < 2; ++ai)
#pragma unroll
            for (int m = 0; m < 4; ++m) { bf16_t* rowp = O + (size_t)(row0 + ai * HALF + m * 16) * ldc + col0;
#pragma unroll
                for (int bj = 0; bj < 2; ++bj) { const f32x4 v0 = acc[ai][bj][m][0], v1 = acc[ai][bj][m][1];
                    u32x4 w; w.x = cvt_pk_bf16(v0[0], v0[1]); w.y = cvt_pk_bf16(v0[2], v0[3]); w.z = cvt_pk_bf16(v1[0], v1[1]); w.w = cvt_pk_bf16(v1[2], v1[3]);
                    *(u32x4*)(rowp + bj * HALF) = w; } }
    }
};

template <bool APERM_>
__device__ __forceinline__ void apply_rstd_sb(f32x4 (&acc)[2][2][4][2], const Unit& u, int wr, int wc, int fr, int fq, const float* SS, const float* sb  , int sbld) {
    float rs[2][4]; f32x4 sv[2][2];
    const int tb = (u.pm % 17 == 0) ? 8 : u.pm / 17;
    const float* sp = sb + (size_t)tb * sbld + u.pn * BM + wc * 32 + 8 * fq;
    {
        f32x4 a[2][4], b[2][4];
#pragma unroll
        for (int ai = 0; ai < 2; ++ai)
#pragma unroll
            for (int m = 0; m < 4; ++m) { const float* q = SS + (size_t)(u.pm * BM + ai * HALF + wr * 64 + (APERM_ ? 4 * fr + m : m * 16 + fr)) * 8; a[ai][m] = *(const f32x4*)q; b[ai][m] = *(const f32x4*)(q + 4); }
#pragma unroll
        for (int bj = 0; bj < 2; ++bj)
#pragma unroll
            for (int n = 0; n < 2; ++n) sv[bj][n] = *(const f32x4*)(sp + bj * HALF + 4 * n);
#pragma unroll
        for (int ai = 0; ai < 2; ++ai)
#pragma unroll
            for (int m = 0; m < 4; ++m) rs[ai][m] = __builtin_amdgcn_rsqf((((a[ai][m][0] + a[ai][m][1]) + (a[ai][m][2] + a[ai][m][3])) + ((b[ai][m][0] + b[ai][m][1]) + (b[ai][m][2] + b[ai][m][3]))) * (1.f / 2048.f) + 1e-6f);
        asm volatile("" : "+v"(rs[0][0]), "+v"(rs[0][1]), "+v"(rs[0][2]), "+v"(rs[0][3]), "+v"(rs[1][0]), "+v"(rs[1][1]), "+v"(rs[1][2]), "+v"(rs[1][3]) :: "memory");
    }
#pragma unroll
    for (int bj = 0; bj < 2; ++bj)
#pragma unroll
        for (int n = 0; n < 2; ++n)
#pragma unroll
            for (int ai = 0; ai < 2; ++ai)
#pragma unroll
                for (int m = 0; m < 4; ++m) acc[ai][bj][m][n] = acc[ai][bj][m][n] * rs[ai][m] + sv[bj][n];
}
__device__ __forceinline__ void ss_pref_issue(const Unit& u, int wid, int lane, const float* SS, const float* sb, int sbld, PG8_LAS float* ssl) {
    __builtin_amdgcn_global_load_lds((const unsigned*)(SS + (size_t)(u.pm * BM) * 8 + (wid * 64 + lane) * 4), (PG8_LAS unsigned*)(ssl + wid * 256), 16, 0, 0);
    if (wid == 0) { const int tb = (u.pm % 17 == 0) ? 8 : u.pm / 17;
        __builtin_amdgcn_global_load_lds((const unsigned*)(sb + (size_t)tb * sbld + u.pn * BM + lane * 4), (PG8_LAS unsigned*)(ssl + 2304), 16, 0, 0); }
}
__device__ __forceinline__ void ss_pref_reduce(int tid, PG8_LAS float* ssl) {
    if (tid < 256) { const f32x4 a = *(const PG8_LAS f32x4*)(ssl + tid * 8), b = *(const PG8_LAS f32x4*)(ssl + tid * 8 + 4);
        ssl[2048 + tid] = __builtin_amdgcn_rsqf((((a[0] + a[1]) + (a[2] + a[3])) + ((b[0] + b[1]) + (b[2] + b[3]))) * (1.f / 2048.f) + 1e-6f); }
}
template <bool APERM_>
__device__ __forceinline__ void apply_rstd_sb_l(f32x4 (&acc)[2][2][4][2], int wr, int wc, int fr, int fq, const PG8_LAS float* ssl) {
    float rs[2][4]; f32x4 sv[2][2];
#pragma unroll
    for (int ai = 0; ai < 2; ++ai) {
        if constexpr (APERM_) { const f32x4 r = *(const PG8_LAS f32x4*)(ssl + 2048 + ai * HALF + wr * 64 + 4 * fr); rs[ai][0] = r[0]; rs[ai][1] = r[1]; rs[ai][2] = r[2]; rs[ai][3] = r[3]; }
        else {
#pragma unroll
            for (int m = 0; m < 4; ++m) rs[ai][m] = ssl[2048 + ai * HALF + wr * 64 + m * 16 + fr]; } }
#pragma unroll
    for (int bj = 0; bj < 2; ++bj)
#pragma unroll
        for (int n = 0; n < 2; ++n) sv[bj][n] = *(const PG8_LAS f32x4*)(ssl + 2304 + bj * HALF + wc * 32 + 8 * fq + 4 * n);
#pragma unroll
    for (int bj = 0; bj < 2; ++bj)
#pragma unroll
        for (int n = 0; n < 2; ++n)
#pragma unroll
            for (int ai = 0; ai < 2; ++ai)
#pragma unroll
                for (int m = 0; m < 4; ++m) acc[ai][bj][m][n] = acc[ai][bj][m][n] * rs[ai][m] + sv[bj][n];
}
template <int LDC> struct EpiStoreBf16N {
    static constexpr bool PREF = true, PERM = true, AFTER_DRAIN = false, APERM = false; static constexpr int ldc = LDC, sbld = SB_LD;
    bf16_t* O; const float* SS; const float* sb; PG8_LAS float* ssl;
    __device__ __forceinline__ void pref_issue(const Unit& u, int wid) const { const int lane = lane_id_l();     ss_pref_issue(u, wid, lane, SS, sb, sbld, ssl); }
    __device__ __forceinline__ void pref_reduce(int wid) const { const int tid = wid * 64 + lane_id_l(); ss_pref_reduce(tid, ssl); }
    __device__ __forceinline__ void operator()(f32x4 (&acc)[2][2][4][2], const Unit& u, int wr, int wc, int fr, int fq) const {
        { const int t_ = lane_id_l(); fr = t_ & 15; fq = t_ >> 4; }
        apply_rstd_sb_l<false>(acc, wr, wc, fr, fq, ssl);
        const int row0 = u.pm * BM + wr * 64 + fr, col0 = u.pn * BM + wc * 32 + 8 * fq;
#pragma unroll
        for (int ai = 0; ai < 2; ++ai)
#pragma unroll
            for (int m = 0; m < 4; ++m) { bf16_t* rowp = O + (size_t)(row0 + ai * HALF + m * 16) * ldc + col0;
#pragma unroll
                for (int bj = 0; bj < 2; ++bj) { const f32x4 v0 = acc[ai][bj][m][0], v1 = acc[ai][bj][m][1];
                    u32x4 w; w.x = cvt_pk_bf16(v0[0], v0[1]); w.y = cvt_pk_bf16(v0[2], v0[3]); w.z = cvt_pk_bf16(v1[0], v1[1]); w.w = cvt_pk_bf16(v1[2], v1[3]);
                    *(u32x4*)(rowp + bj * HALF) = w; } }
    }
};
struct EpiSB {
    static constexpr bool PREF = false, PERM = false, AFTER_DRAIN = false, APERM = false; static constexpr int ldc = SB_LD;
    float* O;
    __device__ __forceinline__ void operator()(const f32x4 (&acc)[2][2][4][2], const Unit& u, int wr, int wc, int fr, int fq) const {
        const int col0 = u.pn * BM + wc * 32 + 4 * fq;
#pragma unroll
        for (int m = 0; m < 4; ++m) { const int row = wr * 64 + m * 16 + fr;
            if (row < 72) {
#pragma unroll
                for (int bj = 0; bj < 2; ++bj)
#pragma unroll
                    for (int n = 0; n < 2; ++n) *(f32x4*)(O + (size_t)row * ldc + col0 + bj * HALF + n * 16) = acc[0][bj][m][n]; } }
    }
};
struct EpiResidNorm {
    static constexpr bool PREF = true, PERM = true, AFTER_DRAIN = false, APERM = false;
    __device__ __forceinline__ void pref_issue(const Unit& u, int wid) const { const int lane = lane_id_l();
        if (u.nt == ntf && wid < 2) { const int tb = (u.pm % 17 == 0) ? 8 : u.pm / 17;
            if (wid == 0) __builtin_amdgcn_global_load_lds((const unsigned*)(gate + (size_t)tb * 12288 + u.pn * BM + lane * 4), (PG8_LAS unsigned*)gwl, 16, 0, 0);
            else if (donorm) __builtin_amdgcn_global_load_lds((const unsigned*)(weff + (size_t)tb * 2048 + u.pn * BM + lane * 4), (PG8_LAS unsigned*)(gwl + 256), 16, 0, 0); } }
    __device__ __forceinline__ void pref_reduce(int) const {}
    bf16_t* X; const float* gate; bf16_t* H; const float* weff; float* SS; PG8_LAS float* red; int donorm; float* slab; int ntf; PG8_LAS float* gwl;
    __device__ __forceinline__ void operator()(const f32x4 (&acc)[2][2][4][2], const Unit& u, int wr, int wc, int fr, int fq) const {
        { const int t_ = lane_id_l(); fr = t_ & 15; fq = t_ >> 4; }
        constexpr int LD = 2048;
        if (u.nt != ntf) {
            float* sp = slab + ((size_t)(u.kb / u.nt) * 2048 + (size_t)(u.pm / 17) * BM) * LD + u.pn * BM + wc * 32 + 8 * fq;
#pragma unroll
            for (int ai = 0; ai < 2; ++ai)
#pragma unroll
                for (int m = 0; m < 4; ++m) { float* rp = sp + (size_t)(ai * HALF + wr * 64 + m * 16 + fr) * LD;
#pragma unroll
                    for (int bj = 0; bj < 2; ++bj) { *(f32x4*)(rp + bj * HALF) = acc[ai][bj][m][0]; *(f32x4*)(rp + bj * HALF + 4) = acc[ai][bj][m][1]; } }
            return;
        }
        const int col0 = u.pn * BM + wc * 32 + 8 * fq;
        u32x4 xrA[2][4][2];
#pragma unroll
        for (int ai = 0; ai < 2; ++ai)
#pragma unroll
            for (int m = 0; m < 4; ++m)
#pragma unroll
                for (int bj = 0; bj < 2; ++bj) xrA[ai][m][bj] = *(const u32x4*)((const char*)X + (unsigned)(((u.pm * BM + ai * HALF + wr * 64 + m * 16 + fr) * LD + col0) * 2 + bj * (HALF * 2)));
#pragma unroll
        for (int ai = 0; ai < 2; ++ai) {
            float ss[4] = {0.f, 0.f, 0.f, 0.f};
#pragma unroll
            for (int bj = 0; bj < 2; ++bj) {
                f32x4 gv[2], wv[2];
#pragma unroll
                for (int n = 0; n < 2; ++n) { gv[n] = *(const PG8_LAS f32x4*)(gwl + bj * HALF + wc * 32 + 8 * fq + 4 * n); wv[n] = donorm ? *(const PG8_LAS f32x4*)(gwl + 256 + bj * HALF + wc * 32 + 8 * fq + 4 * n) : (f32x4){0.f, 0.f, 0.f, 0.f}; }
#pragma unroll
                for (int m = 0; m < 4; ++m) { const int trow = ai * HALF + wr * 64 + m * 16 + fr; const unsigned offb = (unsigned)(((u.pm * BM + trow) * LD + col0) * 2 + bj * (HALF * 2));
                    const u32x4 xv = xrA[ai][m][bj];
                    f32x4 x0, x1;
                    x0[0] = __uint_as_float(xv.x << 16); x0[1] = __uint_as_float(xv.x & 0xffff0000u); x0[2] = __uint_as_float(xv.y << 16); x0[3] = __uint_as_float(xv.y & 0xffff0000u);
                    x1[0] = __uint_as_float(xv.z << 16); x1[1] = __uint_as_float(xv.z & 0xffff0000u); x1[2] = __uint_as_float(xv.w << 16); x1[3] = __uint_as_float(xv.w & 0xffff0000u);
                    x0 = x0 + gv[0] * acc[ai][bj][m][0]; x1 = x1 + gv[1] * acc[ai][bj][m][1];
                    u32x4 xw; xw.x = cvt_pk_bf16(x0[0], x0[1]); xw.y = cvt_pk_bf16(x0[2], x0[3]); xw.z = cvt_pk_bf16(x1[0], x1[1]); xw.w = cvt_pk_bf16(x1[2], x1[3]); *(u32x4*)((char*)X + offb) = xw;
                    if (donorm) { ss[m] += (x0[0] * x0[0] + x0[1] * x0[1]) + (x0[2] * x0[2] + x0[3] * x0[3]) + (x1[0] * x1[0] + x1[1] * x1[1]) + (x1[2] * x1[2] + x1[3] * x1[3]);
                        const f32x4 a0 = x0 * wv[0], a1 = x1 * wv[1];
                        u32x4 w; w.x = cvt_pk_bf16(a0[0], a0[1]); w.y = cvt_pk_bf16(a0[2], a0[3]); w.z = cvt_pk_bf16(a1[0], a1[1]); w.w = cvt_pk_bf16(a1[2], a1[3]);
                        *(u32x4*)((char*)H + offb) = w; } }
                asm volatile("" ::: "memory");
            }
            if (donorm) {
#pragma unroll
                for (int m = 0; m < 4; ++m) { float s_ = ss[m]; s_ += __shfl_xor(s_, 16); s_ += __shfl_xor(s_, 32); if (fq == 0) red[(ai * HALF + wr * 64 + m * 16 + fr) * 4 + wc] = s_; } }
        }
        if (donorm) {
            asm volatile("s_waitcnt lgkmcnt(0)" ::: "memory"); __builtin_amdgcn_s_barrier(); asm volatile("" ::: "memory");
            const int t = (wr * 4 + wc) * 64 + fq * 16 + fr;
            if (t < 256) { const f32x4 r = *(const PG8_LAS f32x4*)(red + t * 4); SS[(size_t)(u.pm * BM + t) * 8 + u.pn] = (r[0] + r[1]) + (r[2] + r[3]); }
        }
    }
};

__device__ __forceinline__ float dpp_ror1(float v) { return __builtin_bit_cast(float, __builtin_amdgcn_update_dpp(0, __builtin_bit_cast(int, v), 0x121, 0xf, 0xf, false)); }
__device__ __forceinline__ float dpp_shr1_old(float old, float v) { return __builtin_bit_cast(float, __builtin_amdgcn_update_dpp(__builtin_bit_cast(int, old), __builtin_bit_cast(int, v), 0x111, 0xf, 0xf, false)); }
__device__ __forceinline__ float dpp_shl1_old(float old, float v) { return __builtin_bit_cast(float, __builtin_amdgcn_update_dpp(__builtin_bit_cast(int, old), __builtin_bit_cast(int, v), 0x101, 0xf, 0xf, false)); }
__device__ __forceinline__ float dpp_rol1(float v) { return __builtin_bit_cast(float, __builtin_amdgcn_update_dpp(0, __builtin_bit_cast(int, v), 0x12f, 0xf, 0xf, false)); }
struct EpiConvGate {
    static constexpr bool PREF = true , PERM = true, AFTER_DRAIN = false, APERM = true;
    bf16_t* ACT; float* HALO; const float* cw; PG8_LAS float* edge; const float* SS; const float* sb; PG8_LAS float* ssl;
    __device__ __forceinline__ void pref_issue(const Unit& u, int wid) const { const int lane = lane_id_l();     ss_pref_issue(u, wid, lane, SS, sb, SB_LD, ssl);
        if (wid >= 1 && wid <= 3) { const int r6 = 2 * (wid - 1) + (lane >> 5);
            __builtin_amdgcn_global_load_lds((const unsigned*)(cw + (size_t)(r6 >> 1) * (2 * 5632) + (r6 & 1) * 5632 + u.pn * 128 + (lane & 31) * 4), (PG8_LAS unsigned*)(ssl + 2560 + (wid - 1) * 256), 16, 0, 0); } }
    __device__ __forceinline__ void pref_reduce(int wid) const { const int tid = wid * 64 + lane_id_l(); ss_pref_reduce(tid, ssl);
        for (int idx = tid; idx < 768; idx += 512) ssl[2560 + idx] *= ((idx >> 7) & 1) ? -0.6931471805599453f : -1.4426950408889634f; }
    __device__ __forceinline__ void operator()(f32x4 (&acc)[2][2][4][2], const Unit& u, int wr, int wc, int fr, int fq) const {
        { const int t_ = lane_id_l(); fr = t_ & 15; fq = t_ >> 4; }
        constexpr int DFF_ = 5632;
        apply_rstd_sb_l<true>(acc, wr, wc, fr, fq, ssl); __builtin_amdgcn_sched_barrier(0);
        const int jl = wc * 32 + 8 * fq, j0 = u.pn * 128 + jl;
        f32x4 wgA[2][3], wuA[2][3];
#pragma unroll
        for (int n = 0; n < 2; ++n)
#pragma unroll
            for (int t = 0; t < 3; ++t) { wgA[n][t] = *(const PG8_LAS f32x4*)(ssl + 2560 + (t * 2) * 128 + jl + 4 * n); wuA[n][t] = *(const PG8_LAS f32x4*)(ssl + 2560 + (t * 2 + 1) * 128 + jl + 4 * n); }
#pragma unroll
        for (int ai = 0; ai < 2; ++ai) { const int s = 2 * ai + wr;
#pragma unroll
            for (int gu = 0; gu < 2; ++gu)
#pragma unroll
                for (int n = 0; n < 2; ++n) {
                    if (fr == 0) *(PG8_LAS f32x4*)(edge + ((s * 2 + 0) * 2 + gu) * 128 + jl + 4 * n) = acc[ai][gu][0][n];
                    if (fr == 15) *(PG8_LAS f32x4*)(edge + ((s * 2 + 1) * 2 + gu) * 128 + jl + 4 * n) = acc[ai][gu][3][n]; } }
        if (wr == 0 && fr == 0) {
#pragma unroll
            for (int m = 0; m < 2; ++m) { float* hp = HALO + ((size_t)(u.pm * 4 + m) * 2) * DFF_ + j0;
#pragma unroll
                for (int gu = 0; gu < 2; ++gu)
#pragma unroll
                    for (int n = 0; n < 2; ++n) *(f32x4*)(hp + (size_t)gu * DFF_ + 4 * n) = acc[0][gu][m][n]; } }
        if (wr == 1 && fr == 15) {
#pragma unroll
            for (int m = 2; m < 4; ++m) { float* hp = HALO + ((size_t)(u.pm * 4 + m) * 2) * DFF_ + j0;
#pragma unroll
                for (int gu = 0; gu < 2; ++gu)
#pragma unroll
                    for (int n = 0; n < 2; ++n) *(f32x4*)(hp + (size_t)gu * DFF_ + 4 * n) = acc[1][gu][m][n]; } }
        if (wr == 0 && wc == 0) { float z_ = 0.f; asm volatile("" : "+v"(z_)); *(PG8_LAS f32x4*)(edge + 2048 + (fq * 16 + fr) * 4) = (f32x4){z_, z_, z_, z_}; }
        asm volatile("s_waitcnt lgkmcnt(0)" ::: "memory"); __builtin_amdgcn_s_barrier(); asm volatile("" ::: "memory");
        const bool f0 = (fr == 0), f15 = (fr == 15);
#define CG_DPP4(dst, src, fn) do { dst[0] = fn(src[0]); dst[1] = fn(src[1]); dst[2] = fn(src[2]); dst[3] = fn(src[3]); } while (0)
#define CG_SEL4(dst, c, a, b) do { dst[0] = (c) ? a[0] : b[0]; dst[1] = (c) ? a[1] : b[1]; dst[2] = (c) ? a[2] : b[2]; dst[3] = (c) ? a[3] : b[3]; } while (0)
#pragma unroll
        for (int ai = 0; ai < 2; ++ai) { const int s = 2 * ai + wr;
            const PG8_LAS float* pa = (s > 0 ? edge + (((s - 1) * 2 + 1) * 2) * 128 : edge + 2048) + jl; const PG8_LAS float* pb = (s < 3 ? edge + (((s + 1) * 2 + 0) * 2) * 128 : edge + 2048) + jl;
            f32x4 eaA[2][2], ebA[2][2];
#pragma unroll
            for (int gu = 0; gu < 2; ++gu)
#pragma unroll
                for (int n = 0; n < 2; ++n) eaA[gu][n] = *(const PG8_LAS f32x4*)(pa + gu * 128 + 4 * n);
#pragma unroll
            for (int m = 0; m < 4; ++m) {
                if (m == 2) {
#pragma unroll
                    for (int gu = 0; gu < 2; ++gu)
#pragma unroll
                        for (int n = 0; n < 2; ++n) ebA[gu][n] = *(const PG8_LAS f32x4*)(pb + gu * 128 + 4 * n); }
                u32x4 w4;
#pragma unroll
                for (int n = 0; n < 2; ++n) {
                    const f32x4* wg = wgA[n]; const f32x4* wu = wuA[n];
                    f32x4 cv[2];
#pragma unroll
                    for (int gu = 0; gu < 2; ++gu) {
                        const f32x4 self = acc[ai][gu][m][n];
                        f32x4 t4, up, dn;
                        if (m == 0) { const f32x4 ea = eaA[gu][n];
                                      up[0] = dpp_shr1_old(ea[0], acc[ai][gu][3][n][0]); up[1] = dpp_shr1_old(ea[1], acc[ai][gu][3][n][1]); up[2] = dpp_shr1_old(ea[2], acc[ai][gu][3][n][2]); up[3] = dpp_shr1_old(ea[3], acc[ai][gu][3][n][3]); }
                        else up = acc[ai][gu][m - 1][n];
                        if (m == 3) { const f32x4 eb = ebA[gu][n];
                                      dn[0] = dpp_shl1_old(eb[0], acc[ai][gu][0][n][0]); dn[1] = dpp_shl1_old(eb[1], acc[ai][gu][0][n][1]); dn[2] = dpp_shl1_old(eb[2], acc[ai][gu][0][n][2]); dn[3] = dpp_shl1_old(eb[3], acc[ai][gu][0][n][3]); }
                        else dn = acc[ai][gu][m + 1][n];
                        const f32x4* w = gu ? wu : wg;
                        cv[gu] = w[0] * up + w[1] * self + w[2] * dn;
                    }
                    const f32x4 ex = cv[0];
                    f32x4 sg; sg[0] = __builtin_amdgcn_exp2f(ex[0]); sg[1] = __builtin_amdgcn_exp2f(ex[1]); sg[2] = __builtin_amdgcn_exp2f(ex[2]); sg[3] = __builtin_amdgcn_exp2f(ex[3]);
                    sg = sg + 1.0f;
                    sg[0] = __builtin_amdgcn_rcpf(sg[0]); sg[1] = __builtin_amdgcn_rcpf(sg[1]); sg[2] = __builtin_amdgcn_rcpf(sg[2]); sg[3] = __builtin_amdgcn_rcpf(sg[3]);
                    const f32x4 o = (cv[0] * sg) * cv[1];
                    w4[2 * n] = cvt_pk_bf16(o[0], o[1]); w4[2 * n + 1] = cvt_pk_bf16(o[2], o[3]);
                }
                const int trow = ai * HALF + wr * 64 + 4 * fr + m;
                if (trow != 0 && trow != 255) *(u32x4*)(ACT + (size_t)(u.pm * BM + trow) * DFF_ + j0) = w4;
            }
        }
#undef CG_DPP4
#undef CG_SEL4
    }
};

struct EpiScIn {
    static constexpr bool PREF = true , PERM = true, AFTER_DRAIN = false, APERM = true, RELAX = true;
    bf16_t* BB; bf16_t* O; float* HALO; const float* cw; PG8_LAS float* edge; const float* SS; const float* sb; PG8_LAS float* ssl;
    __device__ __forceinline__ void pref_issue(const Unit& u, int wid) const { const int lane = lane_id_l();     ss_pref_issue(u, wid, lane, SS, sb, SB_LD, ssl);
        const int q = u.pn / 3, kind = u.pn - 3 * q;
        if (kind != 0 && (wid == 1 || wid == 2)) { const int r = 2 * (wid - 1) + (lane >> 5);
            if (r < 3) __builtin_amdgcn_global_load_lds((const unsigned*)(cw + (size_t)r * 2048 + q * 256 + (kind - 1) * 128 + (lane & 31) * 4), (PG8_LAS unsigned*)(ssl + 2560 + (wid - 1) * 256), 16, 0, 0); } }
    __device__ __forceinline__ void pref_reduce(int wid) const { const int tid = wid * 64 + lane_id_l(); ss_pref_reduce(tid, ssl); }
    __device__ __forceinline__ void operator()(f32x4 (&acc)[2][2][4][2], const Unit& u, int wr, int wc, int fr, int fq) const {
        { const int t_ = lane_id_l(); fr = t_ & 15; fq = t_ >> 4; }
        constexpr int LD = 2048;
        apply_rstd_sb_l<true>(acc, wr, wc, fr, fq, ssl); __builtin_amdgcn_sched_barrier(0);
        { const int t_ = lane_id_l(); fr = t_ & 15; fq = t_ >> 4; }
        const int q = u.pn / 3; int kind = u.pn - 3 * q;
        if (kind == 0) {
            const int col0 = q * 256 + wc * 32 + 8 * fq;
#pragma unroll
            for (int ai = 0; ai < 2; ++ai)
#pragma unroll
                for (int m = 0; m < 4; ++m) { bf16_t* rowp = BB + (size_t)(u.pm * BM + ai * HALF + wr * 64 + 4 * fr + m) * LD + col0;
#pragma unroll
                    for (int bj = 0; bj < 2; ++bj) { const f32x4 v0 = acc[ai][bj][m][0], v1 = acc[ai][bj][m][1];
                        u32x4 w; w.x = cvt_pk_bf16(v0[0], v0[1]); w.y = cvt_pk_bf16(v0[2], v0[3]); w.z = cvt_pk_bf16(v1[0], v1[1]); w.w = cvt_pk_bf16(v1[2], v1[3]);
                        *(u32x4*)(rowp + bj * HALF) = w; } }
        }
        asm volatile("" : "+s"(kind) :: "memory");
        if (kind == 0) return;
        const int jl = wc * 32 + 8 * fq, j0 = q * 256 + (kind - 1) * 128 + jl;
#pragma unroll
        for (int ai = 0; ai < 2; ++ai)
#pragma unroll
            for (int m = 0; m < 4; ++m)
#pragma unroll
                for (int n = 0; n < 2; ++n) acc[ai][0][m][n] = acc[ai][0][m][n] * acc[ai][1][m][n];
#pragma unroll
        for (int ai = 0; ai < 2; ++ai)
            asm volatile("" : "+v"(acc[ai][0][0][0]), "+v"(acc[ai][0][0][1]), "+v"(acc[ai][0][1][0]), "+v"(acc[ai][0][1][1]), "+v"(acc[ai][0][2][0]), "+v"(acc[ai][0][2][1]), "+v"(acc[ai][0][3][0]), "+v"(acc[ai][0][3][1]) :: "memory");
        __builtin_amdgcn_sched_barrier(0);
        f32x4 wt[2][3]; u32x4 bb[2][4];
#pragma unroll
        for (int n = 0; n < 2; ++n)
#pragma unroll
            for (int t = 0; t < 3; ++t) wt[n][t] = *(const PG8_LAS f32x4*)(ssl + 2560 + t * 128 + jl + 4 * n);
#pragma unroll
        for (int ai = 0; ai < 2; ++ai)
#pragma unroll
            for (int m = 0; m < 4; ++m) bb[ai][m] = *(const u32x4*)(BB + (size_t)(u.pm * BM + ai * HALF + wr * 64 + 4 * fr + m) * LD + j0);
#pragma unroll
        for (int ai = 0; ai < 2; ++ai) { const int s = 2 * ai + wr;
#pragma unroll
            for (int n = 0; n < 2; ++n) {
                if (fr == 0) *(PG8_LAS f32x4*)(edge + (s * 2 + 0) * 128 + jl + 4 * n) = acc[ai][0][0][n];
                if (fr == 15) *(PG8_LAS f32x4*)(edge + (s * 2 + 1) * 128 + jl + 4 * n) = acc[ai][0][3][n]; } }
        if (wr == 0 && fr == 0) {
#pragma unroll
            for (int m = 0; m < 2; ++m)
#pragma unroll
                for (int n = 0; n < 2; ++n) *(f32x4*)(HALO + (size_t)(u.pm * 4 + m) * LD + j0 + 4 * n) = acc[0][0][m][n]; }
        if (wr == 1 && fr == 15) {
#pragma unroll
            for (int m = 2; m < 4; ++m)
#pragma unroll
                for (int n = 0; n < 2; ++n) *(f32x4*)(HALO + (size_t)(u.pm * 4 + m) * LD + j0 + 4 * n) = acc[1][0][m][n]; }
        if (wr == 0 && wc == 0) { float z_ = 0.f; asm volatile("" : "+v"(z_)); *(PG8_LAS f32x4*)(edge + 2048 + (fq * 16 + fr) * 4) = (f32x4){z_, z_, z_, z_}; }
        asm volatile("s_waitcnt lgkmcnt(0)" ::: "memory"); __builtin_amdgcn_s_barrier(); asm volatile("" ::: "memory");
        const bool f0 = (fr == 0), f15 = (fr == 15);
#define SC_DPP4(dst, src, fn) do { dst[0] = fn(src[0]); dst[1] = fn(src[1]); dst[2] = fn(src[2]); dst[3] = fn(src[3]); } while (0)
#define SC_SEL4(dst, c, a, b) do { dst[0] = (c) ? a[0] : b[0]; dst[1] = (c) ? a[1] : b[1]; dst[2] = (c) ? a[2] : b[2]; dst[3] = (c) ? a[3] : b[3]; } while (0)
#pragma unroll
        for (int ai = 0; ai < 2; ++ai) { const int s = 2 * ai + wr;
            const PG8_LAS float* pa = (s > 0 ? edge + ((s - 1) * 2 + 1) * 128 : edge + 2048) + jl; const PG8_LAS float* pb = (s < 3 ? edge + ((s + 1) * 2 + 0) * 128 : edge + 2048) + jl;
            f32x4 eaA[2], ebA[2];
#pragma unroll
            for (int n = 0; n < 2; ++n) { eaA[n] = *(const PG8_LAS f32x4*)(pa + 4 * n); ebA[n] = *(const PG8_LAS f32x4*)(pb + 4 * n); }
#pragma unroll
            for (int m = 0; m < 4; ++m) {
                u32x4 w4;
#pragma unroll
                for (int n = 0; n < 2; ++n) {
                    const f32x4 self = acc[ai][0][m][n];
                    f32x4 t4, up, dn;
                    if (m == 0) { const f32x4 ea = eaA[n];
                                  up[0] = dpp_shr1_old(ea[0], acc[ai][0][3][n][0]); up[1] = dpp_shr1_old(ea[1], acc[ai][0][3][n][1]); up[2] = dpp_shr1_old(ea[2], acc[ai][0][3][n][2]); up[3] = dpp_shr1_old(ea[3], acc[ai][0][3][n][3]); }
                    else up = acc[ai][0][m - 1][n];
                    if (m == 3) { const f32x4 eb = ebA[n];
                                  dn[0] = dpp_shl1_old(eb[0], acc[ai][0][0][n][0]); dn[1] = dpp_shl1_old(eb[1], acc[ai][0][0][n][1]); dn[2] = dpp_shl1_old(eb[2], acc[ai][0][0][n][2]); dn[3] = dpp_shl1_old(eb[3], acc[ai][0][0][n][3]); }
                    else dn = acc[ai][0][m + 1][n];
                    const f32x4 cv = wt[n][0] * up + wt[n][1] * self + wt[n][2] * dn;
                    const unsigned b0 = bb[ai][m][2 * n], b1 = bb[ai][m][2 * n + 1];
                    const f32x4 bv = (f32x4){__uint_as_float(b0 << 16), __uint_as_float(b0 & 0xffff0000u), __uint_as_float(b1 << 16), __uint_as_float(b1 & 0xffff0000u)};
                    const f32x4 o = cv * bv;
                    w4[2 * n] = cvt_pk_bf16(o[0], o[1]); w4[2 * n + 1] = cvt_pk_bf16(o[2], o[3]);
                }
                const int trow = ai * HALF + wr * 64 + 4 * fr + m;
                if (trow != 0 && trow != 255) *(u32x4*)(O + (size_t)(u.pm * BM + trow) * LD + j0) = w4;
            }
        }
#undef SC_DPP4
#undef SC_SEL4
    }
};
struct OrderSB {
    static constexpr bool SPLIT = false;
    int set, G, c;
    __device__ __forceinline__ void init(int set_, int c_, int G_) { set = set_; c = c_; G = G_; }
    __device__ __forceinline__ bool next(int i, Unit& u) const {
        const int uu = i * G + c; constexpr int T_IN = NSBT_IN, T_SC = NSBT_SC, T_UP = NSBT_UP;
        const int pn = uu < T_IN ? set * T_IN + uu : (uu < T_IN + T_SC ? 2 * T_IN + set * T_SC + (uu - T_IN) : 2 * T_IN + 2 * T_SC + set * 2 * T_UP + (uu - T_IN - T_SC));
        u.pm = 0; u.pn = pn; u.kb = 0; u.nt = 0; return uu < T_IN + T_SC + 2 * T_UP;
    }
    __device__ __forceinline__ void a_ready(const Unit&) const {}
    __device__ __forceinline__ void done(const Unit&) const {}
};
struct OrderSc {
    static constexpr bool SPLIT = false;
    int nMv, nsu, G, c, latent;
    __device__ __forceinline__ void init(int nMv_, int G_, int c_, int latent_) { nMv = nMv_; nsu = nMv_ * 8; G = G_; c = c_; latent = latent_; }
    __device__ __forceinline__ bool next(int i, Unit& u) const {
        const int si = i / 3, sub = i - 3 * si;
        const long L = (long)si * G + c; if (L >= nsu) return false;
        int wgid = (int)L; { const int q = nsu / NXCD, r = nsu % NXCD, xcd = wgid % NXCD, off = wgid / NXCD; wgid = (xcd < r ? xcd * (q + 1) : r * (q + 1) + (xcd - r) * q) + off; }
        const int nig = WGM * 8, gid = wgid / nig, fm = gid * WGM, gsz = (nMv - fm) < WGM ? (nMv - fm) : WGM;
        const int v = fm + ((wgid % nig) % gsz), q8 = (wgid % nig) / gsz;
        u.pm = latent ? v + (v >> 4) + 1 : v; u.pn = 3 * q8 + sub; u.kb = 0; u.nt = 0; return true;
    }
    __device__ __forceinline__ void a_ready(const Unit&) const {}
    __device__ __forceinline__ void done(const Unit&) const {}
};
struct OrderSplit {
    static constexpr bool SPLIT = true;
    int nN, nfull, G, c, ntf, nctx;
    __device__ __forceinline__ void init(int nN_, int G_, int c_, int ntf_, int nctx_) { nN = nN_; nfull = 128 * nN_; G = G_; c = c_; ntf = ntf_; nctx = nctx_; }
    __device__ __forceinline__ bool next(int i, Unit& u) const {
        const long L = (long)i * G + c;
        if (L >= nfull + (long)nctx * nN * 4) return false;
        const bool full = L < nfull;
        int wgid = (int)L; { const int q = nfull / NXCD, r = nfull % NXCD, xcd = wgid % NXCD, off = wgid / NXCD; wgid = (xcd < r ? xcd * (q + 1) : r * (q + 1) + (xcd - r) * q) + off; }
        const int nig = WGM * nN, gid = wgid / nig, fm = gid * WGM, v = fm + ((wgid % nig) % WGM);
        const int q = (int)(L - nfull), s = q & 3, cu = q >> 2;
        const int pm = full ? v + (v >> 4) + 1 : 17 * (cu & 7), pn = full ? (wgid % nig) / WGM : cu >> 3, nt_ = full ? ntf : (ntf >> 2), kb = full ? 0 : s * (ntf >> 2);
        u.pm = pm; u.pn = pn; u.kb = kb; u.nt = nt_; return true;
    }
    __device__ __forceinline__ void a_ready(const Unit&) const {}
    __device__ __forceinline__ void done(const Unit&) const {}
};
struct Order {
    static constexpr bool SPLIT = false;
    int nMv, nN, nwg, G, c, latent, voff;
    __device__ __forceinline__ void init(int nMv_, int nN_, int G_, int c_, int latent_, int voff_) { nMv = nMv_; nN = nN_; nwg = nMv_ * nN_; G = G_; c = c_; latent = latent_; voff = voff_; }
    __device__ __forceinline__ bool next(int i, Unit& u) const {
        const long L = (long)i * G + c; if (L >= nwg) return false;
        int wgid = (int)L; { const int q = nwg / NXCD, r = nwg % NXCD, xcd = wgid % NXCD, off = wgid / NXCD; wgid = (xcd < r ? xcd * (q + 1) : r * (q + 1) + (xcd - r) * q) + off; }
        const int nig = WGM * nN, gid = wgid / nig, fm = gid * WGM, gsz = (nMv - fm) < WGM ? (nMv - fm) : WGM;
        const int v = fm + ((wgid % nig) % gsz) + voff; u.pn = (wgid % nig) / gsz;
        u.pm = latent ? v + (v >> 4) + 1 : v; u.kb = 0; u.nt = 0; return true;
    }
    __device__ __forceinline__ void a_ready(const Unit&) const {}
    __device__ __forceinline__ void done(const Unit&) const {}
};
template <class Epi, class Sched, bool ALIGN_EPI = false, bool SP2 = false>
__device__ __forceinline__ void gemm_phase(PG8_LAS unsigned char* lds, const Gemm g, const Sched& S, const Epi& E, const int wave_in) {
    int tid_l = wave_in * 64 + lane_id_l(); asm volatile("" : "+v"(tid_l));
    const int tid = tid_l, wid = __builtin_amdgcn_readfirstlane(tid >> 6), lane = tid & 63, wr = wid >> 2, wc = wid & 3, fr = lane & 15, fq = lane >> 4;
    const int K = g.K; int nt = K / BK;
    unsigned voffA[2], voffB[2];
#pragma unroll
    for (int i = 0; i < 2; ++i) { int R, C; stage_rc(tid * 16 + i * 8192, R, C); const int Rb = Epi::PERM ? ((R & ~31) + perm32(R & 31)) : R;
        const int Ra = Epi::APERM ? ((R & 64) | (4 * (R & 15) + ((R >> 4) & 3))) : R;
        voffA[i] = (unsigned)(Ra * K + C) * 2u; voffB[i] = (unsigned)(Rb * K + C) * 2u; }
    const size_t kstep = (size_t)(BK * 2);
    const size_t hstep = (size_t)HALF * K * 2;
    const size_t tstep = 2 * hstep;
    const unsigned ldsw = (unsigned)wid * 1024u;
    const int aoff = lds_byte(wr * 64 + fr, fq * 8), boff = lds_byte(wc * 32 + fr, fq * 8);
#define PG8_SA(b, h) (((b) * 2 + (h)) * HTB)
#define PG8_SB(b, h) ((4 + (b) * 2 + (h)) * HTB)
#define PG8_STAGE(bufoff, gbase, voff) do { _Pragma("unroll") for (int _i = 0; _i < 2; ++_i) \
        __builtin_amdgcn_global_load_lds((const unsigned*)((const char*)(gbase) + (voff)[_i]), (PG8_LAS unsigned*)(lds + (bufoff) + ldsw + _i * 8192), 16, 0, 0); } while (0)
#define PG8_LDA(dst, b, h) do { _Pragma("unroll") for (int m = 0; m < 4; ++m) _Pragma("unroll") for (int k = 0; k < 2; ++k) dst[m][k] = *(const PG8_LAS bf16x8*)(lds + PG8_SA(b, h) + aoff + m * 2048 + k * 1024); } while (0)
#define PG8_LDB(dst, b, h) do { _Pragma("unroll") for (int n = 0; n < 2; ++n) _Pragma("unroll") for (int k = 0; k < 2; ++k) dst[n][k] = *(const PG8_LAS bf16x8*)(lds + PG8_SB(b, h) + boff + n * 2048 + k * 1024); } while (0)
#define PG8_MMA(ai, bj, At, Bt) do { __builtin_amdgcn_s_setprio(1); _Pragma("unroll") for (int m = 0; m < 4; ++m) _Pragma("unroll") for (int n = 0; n < 2; ++n) _Pragma("unroll") for (int k = 0; k < 2; ++k) \
        acc[ai][bj][m][n] = __builtin_amdgcn_mfma_f32_16x16x32_bf16(Bt[n][k], At[m][k], acc[ai][bj][m][n], 0, 0, 0); __builtin_amdgcn_s_setprio(0); } while (0)
#define PG8_WAIT_V(n) asm volatile("s_waitcnt vmcnt(" #n ")" ::: "memory")
#define PG8_WAIT_L(n) asm volatile("s_waitcnt lgkmcnt(" #n ")" ::: "memory")
#define PG8_BAR __builtin_amdgcn_s_barrier()
#define PG8_SCHED __builtin_amdgcn_sched_barrier(0)
    Unit cur, nxt; int ui = 0;
    if (!S.next(0, cur)) return;
    if constexpr (Sched::SPLIT) nt = cur.nt;
    f32x4 acc[2][2][4][2];
#pragma unroll
    for (int a = 0; a < 2; ++a)
#pragma unroll
        for (int b = 0; b < 2; ++b)
#pragma unroll
            for (int m = 0; m < 4; ++m)
#pragma unroll
                for (int n = 0; n < 2; ++n) acc[a][b][m][n] = (f32x4){0.f, 0.f, 0.f, 0.f};
    bf16x8 At[4][2], B0[2][2], B1[2][2];
    const char* cA = (const char*)g.A + (size_t)cur.pm * tstep; const char* cB = (const char*)g.Bt + (size_t)cur.pn * tstep;
    if constexpr (Sched::SPLIT) { cA += (size_t)cur.kb * kstep; cB += (size_t)cur.kb * kstep; }
    S.a_ready(cur);
    if constexpr (SP2) {
        PG8_STAGE(PG8_SB(0, 0), cB, voffB); PG8_STAGE(PG8_SB(0, 1), cB + hstep, voffB); PG8_STAGE(PG8_SA(0, 0), cA, voffA); PG8_STAGE(PG8_SA(0, 1), cA + hstep, voffA);
        if (wr == 1) PG8_BAR;
        PG8_WAIT_V(2); PG8_BAR;
        PG8_STAGE(PG8_SB(1, 0), cB + kstep, voffB); PG8_STAGE(PG8_SA(1, 0), cA + kstep, voffA); PG8_STAGE(PG8_SB(1, 1), cB + hstep + kstep, voffB);
        PG8_WAIT_V(6); PG8_BAR;
    } else {
        PG8_STAGE(PG8_SB(0, 0), cB, voffB); PG8_STAGE(PG8_SA(0, 0), cA, voffA); PG8_STAGE(PG8_SB(0, 1), cB + hstep, voffB); PG8_STAGE(PG8_SA(0, 1), cA + hstep, voffA);
        if (wr == 1) PG8_BAR;
        PG8_WAIT_V(4); PG8_BAR;
        PG8_STAGE(PG8_SB(1, 0), cB + kstep, voffB); PG8_STAGE(PG8_SA(1, 0), cA + kstep, voffA); PG8_STAGE(PG8_SB(1, 1), cB + hstep + kstep, voffB);
        PG8_WAIT_V(6); PG8_BAR;
    }
    for (;;) {
        const bool has_next = S.next(ui + 1, nxt);
        const char* nA = has_next ? (const char*)g.A + (size_t)nxt.pm * tstep : cA; const char* nB = has_next ? (const char*)g.Bt + (size_t)nxt.pn * tstep : cB;
        if constexpr (Sched::SPLIT) { if (has_next) { nA += (size_t)nxt.kb * kstep; nB += (size_t)nxt.kb * kstep; } }
        for (int t = 0; t < nt; t += 2) {
            const bool last = (t == nt - 2);
            const char* a1 = cA + (size_t)(t + 1) * kstep;
            const char* a2 = last ? nA : cA + (size_t)(t + 2) * kstep; const char* b2 = last ? nB : cB + (size_t)(t + 2) * kstep;
            const char* a3 = a2 + kstep; const char* b3 = b2 + kstep;
            if (last && has_next) S.a_ready(nxt);
            if constexpr (Epi::PREF) { if (t == 2) E.pref_issue(cur, wid); else if (t == 4) E.pref_reduce(wid); }
            if constexpr (SP2) {
            PG8_LDB(B0, 0, 0); PG8_LDB(B1, 0, 1); PG8_SCHED; PG8_LDA(At, 0, 0); PG8_STAGE(PG8_SA(1, 1), a1 + hstep, voffA);
            PG8_WAIT_V(8); PG8_WAIT_L(0); PG8_BAR; PG8_MMA(0, 0, At, B0); PG8_MMA(0, 1, At, B1); PG8_BAR; PG8_SCHED;
            PG8_LDA(At, 0, 1); PG8_STAGE(PG8_SB(0, 0), b2, voffB); PG8_STAGE(PG8_SB(0, 1), b2 + hstep, voffB); PG8_STAGE(PG8_SA(0, 0), a2, voffA);
            PG8_WAIT_V(8); PG8_WAIT_L(0); PG8_BAR; PG8_MMA(1, 0, At, B0); PG8_MMA(1, 1, At, B1); PG8_BAR; PG8_SCHED;
            PG8_LDB(B0, 1, 0); PG8_LDB(B1, 1, 1); PG8_SCHED; PG8_LDA(At, 1, 0); PG8_STAGE(PG8_SA(0, 1), a2 + hstep, voffA);
            PG8_WAIT_V(8); PG8_WAIT_L(0); PG8_BAR; PG8_MMA(0, 0, At, B0); PG8_MMA(0, 1, At, B1); PG8_BAR; PG8_SCHED;
            PG8_LDA(At, 1, 1); PG8_STAGE(PG8_SB(1, 0), b3, voffB); PG8_STAGE(PG8_SB(1, 1), b3 + hstep, voffB); PG8_STAGE(PG8_SA(1, 0), a3, voffA);
            PG8_WAIT_V(8); PG8_WAIT_L(0); PG8_BAR; PG8_MMA(1, 0, At, B0); PG8_MMA(1, 1, At, B1); PG8_BAR; PG8_SCHED;
            } else {
            PG8_LDB(B0, 0, 0); PG8_SCHED; PG8_LDA(At, 0, 0); PG8_STAGE(PG8_SA(1, 1), a1 + hstep, voffA);
            PG8_WAIT_L(8); PG8_BAR; PG8_WAIT_L(0); PG8_MMA(0, 0, At, B0); PG8_BAR; PG8_SCHED;
            PG8_LDB(B1, 0, 1); PG8_STAGE(PG8_SB(0, 0), b2, voffB);
            PG8_BAR; PG8_WAIT_L(0); PG8_MMA(0, 1, At, B1); PG8_BAR;
            PG8_LDA(At, 0, 1); PG8_STAGE(PG8_SA(0, 0), a2, voffA);
            PG8_BAR; PG8_WAIT_L(0); PG8_MMA(1, 0, At, B0); PG8_BAR; PG8_SCHED;
            PG8_STAGE(PG8_SB(0, 1), b2 + hstep, voffB);
            PG8_WAIT_V(6); PG8_BAR; PG8_MMA(1, 1, At, B1); PG8_BAR;
            PG8_LDB(B0, 1, 0); PG8_SCHED; PG8_LDA(At, 1, 0); PG8_STAGE(PG8_SA(0, 1), a2 + hstep, voffA);
            PG8_WAIT_L(8); PG8_BAR; PG8_WAIT_L(0); PG8_MMA(0, 0, At, B0); PG8_BAR; PG8_SCHED;
            PG8_LDB(B1, 1, 1); PG8_STAGE(PG8_SB(1, 0), b3, voffB);
            PG8_BAR; PG8_WAIT_L(0); PG8_MMA(0, 1, At, B1); PG8_BAR;
            PG8_LDA(At, 1, 1); PG8_STAGE(PG8_SA(1, 0), a3, voffA);
            PG8_BAR; PG8_WAIT_L(0); PG8_MMA(1, 0, At, B0); PG8_BAR; PG8_SCHED;
            PG8_STAGE(PG8_SB(1, 1), b3 + hstep, voffB);
            PG8_WAIT_V(6); PG8_BAR; PG8_MMA(1, 1, At, B1); PG8_BAR;
            }
        }
        if constexpr (ALIGN_EPI) { if (wr == 0) PG8_BAR; }
        if constexpr (!Epi::AFTER_DRAIN) { E(acc, cur, wr, wc, fr, fq); S.done(cur); }
        if (!has_next) break;
#pragma unroll
        for (int a = 0; a < 2; ++a)
#pragma unroll
            for (int b = 0; b < 2; ++b)
#pragma unroll
                for (int m = 0; m < 4; ++m)
#pragma unroll
                    for (int n = 0; n < 2; ++n) acc[a][b][m][n] = (f32x4){0.f, 0.f, 0.f, 0.f};
        cur = nxt; cA = nA; cB = nB; ++ui;
        if constexpr (Sched::SPLIT) nt = cur.nt;
        if constexpr (ALIGN_EPI) { if (wr == 1) PG8_BAR; }
    }
    PG8_WAIT_V(0);
    if constexpr (!ALIGN_EPI) { if (wr == 0) PG8_BAR; }
    PG8_BAR;
    if constexpr (Epi::AFTER_DRAIN) { E.fused(acc, cur, wr, wc, fr, fq, lds, wid, lane); S.done(cur); }
#undef PG8_SA
#undef PG8_SB
#undef PG8_STAGE
#undef PG8_LDA
#undef PG8_LDB
#undef PG8_MMA
#undef PG8_WAIT_V
#undef PG8_WAIT_L
#undef PG8_BAR
#undef PG8_SCHED
}
}

namespace att {
typedef unsigned short bf16_t;
using bf16x8 = __attribute__((ext_vector_type(8))) short;
using s16x4  = __attribute__((ext_vector_type(4))) short;
using f32x16 = __attribute__((ext_vector_type(16))) float;
using u32x4  = __attribute__((ext_vector_type(4))) unsigned;
constexpr int NW = 8, QBLK = 32, KVBLK = 64, DV = 128;
constexpr int SHM_V = KVBLK * DV * 2;
constexpr float THR = 8.f;
#define ATT_SBAR() __builtin_amdgcn_sched_barrier(0)
__device__ __forceinline__ int crow(int r, int hi) { return (r & 3) + 8 * (r >> 2) + 4 * hi; }
__device__ __forceinline__ unsigned cvtpk(float lo, float hi) { unsigned r; asm volatile("v_cvt_pk_bf16_f32 %0, %1, %2" : "=v"(r) : "v"(lo), "v"(hi)); return r; }
template <int DQK> __device__ __forceinline__ int kswz(int row, int colB) { return row * (DQK * 2) + (colB ^ ((DQK == 128 ? (row & 15) : ((row >> 1) & 7)) << 4)); }

__device__ __forceinline__ void partialSM(f32x16& p0, f32x16& p1, float& m_reg, float& mn, float& alpha, const float C, const float thr_raw) {
  float pmax = p0[0];
#pragma unroll
  for (int r = 1; r < 16; ++r) pmax = fmaxf(pmax, p0[r]);
#pragma unroll
  for (int r = 0; r < 16; ++r) pmax = fmaxf(pmax, p1[r]);
  { auto rr = __builtin_amdgcn_permlane32_swap(__float_as_uint(pmax), __float_as_uint(pmax), false, false);
    pmax = fmaxf(__uint_as_float(rr[0]), __uint_as_float(rr[1])); }
  if (__builtin_expect(__all(pmax - m_reg <= thr_raw), 1)) { mn = m_reg; alpha = 1.f; }
  else { mn = fmaxf(m_reg, pmax); alpha = __builtin_amdgcn_exp2f((m_reg - mn) * C); m_reg = mn; }
  const float mnC = -mn * C;
#pragma unroll
  for (int r = 0; r < 16; ++r) p0[r] = fmaf(p0[r], C, mnC);
#pragma unroll
  for (int r = 0; r < 16; ++r) p1[r] = fmaf(p1[r], C, mnC);
#pragma unroll
  for (int r = 0; r < 16; ++r) p0[r] = __builtin_amdgcn_exp2f(p0[r]);
}
__device__ __forceinline__ void finishSM(f32x16& p0, f32x16& p1, float alpha, float& l_reg, bf16x8& pa0, bf16x8& pa1, bf16x8& pa2, bf16x8& pa3) {
#pragma unroll
  for (int r = 0; r < 16; ++r) p1[r] = __builtin_amdgcn_exp2f(p1[r]);
  float ps = 0;
#pragma unroll
  for (int r = 0; r < 16; ++r) ps += p0[r];
#pragma unroll
  for (int r = 0; r < 16; ++r) ps += p1[r];
  { auto rr = __builtin_amdgcn_permlane32_swap(__float_as_uint(ps), __float_as_uint(ps), false, false);
    ps = __uint_as_float(rr[0]) + __uint_as_float(rr[1]); }
  l_reg = l_reg * alpha + ps;
#define ATT_PK4(P, BASE, OUT) do { unsigned a0 = cvtpk(P[BASE + 0], P[BASE + 1]), a1 = cvtpk(P[BASE + 2], P[BASE + 3]);   \
    unsigned b0 = cvtpk(P[BASE + 4], P[BASE + 5]), b1 = cvtpk(P[BASE + 6], P[BASE + 7]);                              \
    auto r0 = __builtin_amdgcn_permlane32_swap(a0, b0, false, false); auto r1 = __builtin_amdgcn_permlane32_swap(a1, b1, false, false); \
    u32x4 w = {r0[0], r1[0], r0[1], r1[1]}; OUT = *reinterpret_cast<bf16x8*>(&w); } while (0)
  ATT_PK4(p0, 0, pa0); ATT_PK4(p0, 8, pa1); ATT_PK4(p1, 0, pa2); ATT_PK4(p1, 8, pa3);
#undef ATT_PK4
}
template <int DQK>
__device__ __forceinline__ void qkt(f32x16& p0, f32x16& p1, const char* Ks, const bf16x8* qr, int r32, int hi) {
  p0 = f32x16{}; p1 = f32x16{};
#pragma unroll
  for (int d0 = 0; d0 < DQK / 16; ++d0) { const int cb = (d0 * 16 + hi * 8) * 2;
    const bf16x8 b0 = *reinterpret_cast<const bf16x8*>(Ks + kswz<DQK>(r32, cb));
    const bf16x8 b1 = *reinterpret_cast<const bf16x8*>(Ks + kswz<DQK>(32 + r32, cb));
    p0 = __builtin_amdgcn_mfma_f32_32x32x16_bf16(b0, qr[d0], p0, 0, 0, 0);
    p1 = __builtin_amdgcn_mfma_f32_32x32x16_bf16(b1, qr[d0], p1, 0, 0, 0); }
}
__device__ __forceinline__ int v_st(int k, int c) { const int kk = (k & ~0xC) | ((k & 4) << 1) | ((k & 8) >> 1); return ((kk >> 3) * 4 + (c >> 5)) * 512 + ((kk & 7) * 32 + (c & 31)) * 2; }
__device__ __forceinline__ int v_rd_base(int lane) { return ((lane & 3) << 3) | (((lane >> 2) & 3) << 6) | (((lane >> 4) & 1) << 5) | (((lane >> 5) & 1) << 8); }
constexpr int v_rd_off(int d0, int ks, int half) { return d0 * 512 + ks * 4096 + half * 2048; }
template <int OFF> __device__ __forceinline__ s16x4 tr_read(int vb) {
  s16x4 r; asm volatile("ds_read_b64_tr_b16 %0, %1 offset:%2" : "=&v"(r) : "v"(vb), "i"(OFF) : "memory"); return r;
}
template <int D0> __device__ __forceinline__ void pv_one(f32x16& od, int vb, bf16x8 pa0, bf16x8 pa1, bf16x8 pa2, bf16x8 pa3) {
  const s16x4 l0 = tr_read<v_rd_off(D0, 0, 0)>(vb), h0 = tr_read<v_rd_off(D0, 0, 1)>(vb), l1 = tr_read<v_rd_off(D0, 1, 0)>(vb), h1 = tr_read<v_rd_off(D0, 1, 1)>(vb);
  const s16x4 l2 = tr_read<v_rd_off(D0, 2, 0)>(vb), h2 = tr_read<v_rd_off(D0, 2, 1)>(vb), l3 = tr_read<v_rd_off(D0, 3, 0)>(vb), h3 = tr_read<v_rd_off(D0, 3, 1)>(vb);
  asm volatile("s_waitcnt lgkmcnt(0)" ::: "memory"); ATT_SBAR();
#define ATT_PK(L, H) (bf16x8){L[0], L[1], L[2], L[3], H[0], H[1], H[2], H[3]}
  od = __builtin_amdgcn_mfma_f32_32x32x16_bf16(pa0, ATT_PK(l0, h0), od, 0, 0, 0);
  od = __builtin_amdgcn_mfma_f32_32x32x16_bf16(pa1, ATT_PK(l1, h1), od, 0, 0, 0);
  od = __builtin_amdgcn_mfma_f32_32x32x16_bf16(pa2, ATT_PK(l2, h2), od, 0, 0, 0);
  od = __builtin_amdgcn_mfma_f32_32x32x16_bf16(pa3, ATT_PK(l3, h3), od, 0, 0, 0);
#undef ATT_PK
}
__device__ __forceinline__ void pv_d0(f32x16* o, int vb, bf16x8 pa0, bf16x8 pa1, bf16x8 pa2, bf16x8 pa3) {
  pv_one<0>(o[0], vb, pa0, pa1, pa2, pa3); pv_one<1>(o[1], vb, pa0, pa1, pa2, pa3); pv_one<2>(o[2], vb, pa0, pa1, pa2, pa3); pv_one<3>(o[3], vb, pa0, pa1, pa2, pa3);
}
__device__ __forceinline__ bf16x8 ld8(const bf16_t* p) { return *reinterpret_cast<const bf16x8*>(p); }

template <int DQK, int SDEPTH, int LDQ, int LDK, int LDV, int LDO>
__device__ __forceinline__ void attn_unit(const bf16_t* __restrict__ Qb, const bf16_t* __restrict__ Kh, const bf16_t* __restrict__ Kr,
                                          const bf16_t* __restrict__ Vh, bf16_t* __restrict__ Ob, int seq, float scale, char* lds, const int wave_in, const float* ropeB, const int pos0, const float* qnw) {
  constexpr int SHM_K = KVBLK * DQK * 2, NQ = DQK / 16;
  int tid_l = wave_in * 64 + pg8::lane_id_l(); asm volatile("" : "+v"(tid_l));
  const int tid = tid_l, wid = __builtin_amdgcn_readfirstlane(tid >> 6), lane = tid & 63, r32 = lane & 31, hi = lane >> 5;
  char* V_lds = lds; char* K_lds = lds + 2 * SHM_V;
  float* ws = (float*)(lds + 2 * SHM_V + 2 * SHM_K) + wid * 64; float* li_l = ws; float* al_l = ws + 32;
  const float C = scale * 1.4426950408889634f, thr_raw = THR / scale;
  float m_reg = -1e30f, l_reg = 0; f32x16 o[4] = {}; bf16x8 qr[NQ];
  const bf16_t* Qw = Qb + (long)(wid * QBLK) * LDQ + (unsigned)(r32 * LDQ + hi * 8);
#pragma unroll
  for (int d0 = 0; d0 < NQ; ++d0) qr[d0] = ld8(Qw + d0 * 16);
  typedef float f32x4_t __attribute__((ext_vector_type(4)));
  f32x4_t cr[4], cc[4];
  if constexpr (DQK == 192) {
    const int pos = (pos0 >= 0 ? pos0 : 0) + wid * QBLK + r32; const float* tr = ropeB + ((pos >> 6) * 16 + hi * 8) * 2; const float* tc = ropeB + ((pos & 63) * 16 + hi * 8) * 2;
#pragma unroll
    for (int i = 0; i < 4; ++i) { cr[i] = *(const f32x4_t*)(tr + 4 * i); cc[i] = *(const f32x4_t*)(tc + 4 * i); }
  }
  const int sr = tid >> 4, sc = (tid & 15) * 8, vst0 = v_st(sr, sc), vst1 = v_st(32 + sr, sc);
  const int krr = tid >> 3, krc = (tid & 7) * 8;
  const int vb0 = (int)(uintptr_t)V_lds + v_rd_base(lane);
  struct { bf16x8 vs0, vs1, ks0, ks1, ks2; } sr_[SDEPTH];
  const unsigned offV = (unsigned)(sr * LDV + sc), offK = (unsigned)(sr * LDK + sc), offR = (unsigned)(krr * 64 + krc);
#define ATT_SLOAD(i, k0) do { const bf16_t* Vt_ = Vh + (long)(k0) * LDV; const bf16_t* Kt_ = Kh + (long)(k0) * LDK; \
    sr_[i].vs0 = ld8(Vt_ + offV); sr_[i].vs1 = ld8(Vt_ + 32 * LDV + offV); sr_[i].ks0 = ld8(Kt_ + offK); sr_[i].ks1 = ld8(Kt_ + 32 * LDK + offK); \
    if constexpr (DQK == 192) sr_[i].ks2 = ld8(Kr + (long)(k0) * 64 + offR); } while (0)
#define ATT_SWRITE(b, i) do { *(bf16x8*)(V_lds + (b) * SHM_V + vst0) = sr_[i].vs0;          \
    *(bf16x8*)(V_lds + (b) * SHM_V + vst1) = sr_[i].vs1; const int kc_ = sc * 2;               \
    *(bf16x8*)(K_lds + (b) * SHM_K + kswz<DQK>(sr, kc_)) = sr_[i].ks0;                       \
    *(bf16x8*)(K_lds + (b) * SHM_K + kswz<DQK>(32 + sr, kc_)) = sr_[i].ks1;                  \
    if constexpr (DQK == 192) *(bf16x8*)(K_lds + (b) * SHM_K + kswz<DQK>(krr, (128 + krc) * 2)) = sr_[i].ks2; } while (0)
#define ATT_SWAIT() do { if constexpr (SDEPTH == 2) { if constexpr (DQK == 192) asm volatile("s_waitcnt vmcnt(5)" ::: "memory"); else asm volatile("s_waitcnt vmcnt(4)" ::: "memory"); } \
    else asm volatile("s_waitcnt vmcnt(0)" ::: "memory"); } while (0)
#define ATT_RESC(a) do { if (__any((a) < 1.f)) { if (hi == 0) al_l[r32] = (a); asm volatile("s_waitcnt lgkmcnt(0)" ::: "memory"); \
    _Pragma("unroll") for (int d = 0; d < 4; ++d) _Pragma("unroll") for (int r = 0; r < 16; ++r) o[d][r] *= al_l[crow(r, hi)]; } } while (0)
  f32x16 pA0, pA1, pB0, pB1; float mnA, mnB, alA, alB; bf16x8 pa0, pa1, pa2, pa3; const int NT = seq / KVBLK;
  if (wid >= 4) __builtin_amdgcn_s_setprio(1);
  constexpr int SE = 0, SO = SDEPTH - 1;
  ATT_SLOAD(SE, 0); if constexpr (SDEPTH == 2) ATT_SLOAD(SO, KVBLK);
  if constexpr (DQK == 128) { if (qnw != nullptr) {
    float ss = 0.f;
#pragma unroll
    for (int d0 = 0; d0 < 8; ++d0)
#pragma unroll
      for (int e = 0; e < 8; ++e) { const float v = __uint_as_float((unsigned)(unsigned short)qr[d0][e] << 16); ss += v * v; }
    ss += __shfl_xor(ss, 32);
    const float rstd = 1.0f / sqrtf(ss * (1.f / 128.f) + 1e-6f);
    const bool dr = pos0 >= 0;
#pragma unroll
    for (int blk = 0; blk < 2; ++blk)
#pragma unroll
      for (int par = 0; par < 2; ++par) { const int dl = blk * 4 + par, dh = dl + 2;
        const int pos = (dr ? pos0 : 0) + wid * QBLK + r32; const float* tp = ropeB + (((blk == 0 ? pos >> 6 : pos & 63) * 32 + par * 16 + hi * 8) * 2);
        f32x4_t qtp[4], qwl[2], qwh[2];
#pragma unroll
        for (int i = 0; i < 4; ++i) qtp[i] = *(const f32x4_t*)(tp + 4 * i);
        qwl[0] = *(const f32x4_t*)(qnw + dl * 16 + hi * 8); qwl[1] = *(const f32x4_t*)(qnw + dl * 16 + hi * 8 + 4); qwh[0] = *(const f32x4_t*)(qnw + dh * 16 + hi * 8); qwh[1] = *(const f32x4_t*)(qnw + dh * 16 + hi * 8 + 4);
        u32x4 nl, nh;
#pragma unroll
        for (int e2 = 0; e2 < 4; ++e2) { float yl[2], yh[2];
#pragma unroll
          for (int h2 = 0; h2 < 2; ++h2) { const int e = 2 * e2 + h2;
            const float xl = __uint_as_float((unsigned)(unsigned short)qr[dl][e] << 16) * rstd * qwl[e >> 2][e & 3], xh = __uint_as_float((unsigned)(unsigned short)qr[dh][e] << 16) * rstd * qwh[e >> 2][e & 3];
            const float c = dr ? qtp[e >> 1][(e & 1) * 2] : 1.f, s = dr ? qtp[e >> 1][(e & 1) * 2 + 1] : 0.f;
            yl[h2] = xl * c - xh * s; yh[h2] = xh * c + xl * s; }
          nl[e2] = cvtpk(yl[0], yl[1]); nh[e2] = cvtpk(yh[0], yh[1]); }
        qr[dl] = *reinterpret_cast<bf16x8*>(&nl); qr[dh] = *reinterpret_cast<bf16x8*>(&nh); }
  } }
  if constexpr (DQK == 192) {
    if (pos0 >= 0) {
      bf16x8 qa = qr[8], qb = qr[9], qc = qr[10], qd = qr[11]; u32x4 na, nb, nc, nd;
#pragma unroll
      for (int e2 = 0; e2 < 4; ++e2) {
        float o[4][2];
#pragma unroll
        for (int h2 = 0; h2 < 2; ++h2) { const int e = 2 * e2 + h2;
          const float va = __uint_as_float((unsigned)(unsigned short)qa[e] << 16), vb = __uint_as_float((unsigned)(unsigned short)qb[e] << 16);
          const float vc = __uint_as_float((unsigned)(unsigned short)qc[e] << 16), vd = __uint_as_float((unsigned)(unsigned short)qd[e] << 16);
          const float cR = cr[e >> 1][(e & 1) * 2], sR = cr[e >> 1][(e & 1) * 2 + 1], cC = cc[e >> 1][(e & 1) * 2], sC = cc[e >> 1][(e & 1) * 2 + 1];
          o[0][h2] = va * cR - vb * sR; o[1][h2] = vb * cR + va * sR; o[2][h2] = vc * cC - vd * sC; o[3][h2] = vd * cC + vc * sC; }
        na[e2] = cvtpk(o[0][0], o[0][1]); nb[e2] = cvtpk(o[1][0], o[1][1]); nc[e2] = cvtpk(o[2][0], o[2][1]); nd[e2] = cvtpk(o[3][0], o[3][1]);
      }
      qr[8] = *reinterpret_cast<bf16x8*>(&na); qr[9] = *reinterpret_cast<bf16x8*>(&nb); qr[10] = *reinterpret_cast<bf16x8*>(&nc); qr[11] = *reinterpret_cast<bf16x8*>(&nd);
    }
  }
  if constexpr (SDEPTH == 2) { if constexpr (DQK == 192) asm volatile("s_waitcnt vmcnt(5)" ::: "memory"); else asm volatile("s_waitcnt vmcnt(4)" ::: "memory"); } else asm volatile("s_waitcnt vmcnt(0)" ::: "memory");
  ATT_SWRITE(0, SE); __syncthreads();
  qkt<DQK>(pA0, pA1, K_lds, qr, r32, hi); partialSM(pA0, pA1, m_reg, mnA, alA, C, thr_raw);
  if constexpr (SDEPTH == 2) { if (2 < NT) ATT_SLOAD(SE, 2 * KVBLK); } else ATT_SLOAD(SO, KVBLK);
  ATT_SWAIT(); ATT_SWRITE(1, SO); __syncthreads();
  for (int j = 1; j + 1 < NT; j += 2) {
    ATT_SBAR(); qkt<DQK>(pB0, pB1, K_lds + SHM_K, qr, r32, hi);
    finishSM(pA0, pA1, alA, l_reg, pa0, pa1, pa2, pa3); ATT_SBAR();
    ATT_SLOAD(SO, (j + SDEPTH) * KVBLK); ATT_SBAR();
    pv_d0(o, vb0, pa0, pa1, pa2, pa3); partialSM(pB0, pB1, m_reg, mnB, alB, C, thr_raw);
    __syncthreads(); ATT_SWAIT(); ATT_SWRITE(0, SE);
    ATT_RESC(alB); __syncthreads();
    ATT_SBAR(); qkt<DQK>(pA0, pA1, K_lds, qr, r32, hi);
    finishSM(pB0, pB1, alB, l_reg, pa0, pa1, pa2, pa3); ATT_SBAR();
    if (SDEPTH == 1 || j + 3 < NT) ATT_SLOAD(SE, (j + 1 + SDEPTH) * KVBLK); ATT_SBAR();
    pv_d0(o, vb0 + SHM_V, pa0, pa1, pa2, pa3); partialSM(pA0, pA1, m_reg, mnA, alA, C, thr_raw);
    __syncthreads(); ATT_SWAIT(); ATT_SWRITE(1, SO);
    ATT_RESC(alA); __syncthreads();
  }
  ATT_SBAR(); qkt<DQK>(pB0, pB1, K_lds + SHM_K, qr, r32, hi);
  finishSM(pA0, pA1, alA, l_reg, pa0, pa1, pa2, pa3); ATT_SBAR();
  pv_d0(o, vb0, pa0, pa1, pa2, pa3); partialSM(pB0, pB1, m_reg, mnB, alB, C, thr_raw);
  __syncthreads(); ATT_RESC(alB);
  finishSM(pB0, pB1, alB, l_reg, pa0, pa1, pa2, pa3); ATT_SBAR();
  pv_d0(o, vb0 + SHM_V, pa0, pa1, pa2, pa3);
  if (hi == 0) li_l[r32] = l_reg; asm volatile("s_waitcnt lgkmcnt(0)" ::: "memory");
  float rli[16];
#pragma unroll
  for (int r = 0; r < 16; ++r) rli[r] = __builtin_amdgcn_rcpf(li_l[crow(r, hi)]);
  bf16_t* Ow = Ob + (long)(wid * QBLK) * LDO; const unsigned offO = (unsigned)(4 * hi * LDO + r32);
#pragma unroll
  for (int r = 0; r < 16; ++r) { bf16_t* Or = Ow + ((r & 3) + 8 * (r >> 2)) * LDO;
#pragma unroll
    for (int d0 = 0; d0 < 4; ++d0) Or[offO + d0 * 32] = (bf16_t)(cvtpk(o[d0][r] * rli[r], 0.f) & 0xffffu); }
  __builtin_amdgcn_s_setprio(0);
  __syncthreads();
#undef ATT_SLOAD
#undef ATT_SWRITE
#undef ATT_SWAIT
#undef ATT_RESC
}
#undef ATT_SBAR
}

constexpr int NWAVES = 8;
#ifndef MK_ONE_LAUNCH
#define MK_ONE_LAUNCH 1
#endif
constexpr int DM = 2048, NB = 8, SEQ = 4096, CTXL = 256, TPB = SEQ + CTXL  ;
constexpr int MR = NB * TPB  , NTM = MR / 256  ;
constexpr int DFF = 5632, NUP = 2 * DFF, NPROJ = 2368, NPROJP = 2560, NSC = 6144;
constexpr int NQB = 1536, NKVB = 2048;
constexpr float EPS = 1e-6f;
constexpr int MODW = 6 * DM;
constexpr int NPH = 36;

constexpr size_t MiB = 1u << 20;
constexpr size_t WS_CTL = 0, CTL_ZERO_BYTES = 1 * MiB;
constexpr int CW_BAR = 4096;
constexpr size_t WS_MOD = 1 * MiB;
constexpr size_t WS_TAB = 3 * MiB;
constexpr size_t WS_WEFF = 3 * MiB + 65536;
constexpr size_t WS_SHIFT = 4 * MiB;
constexpr size_t WS_SS = 5 * MiB;
constexpr size_t WS_SB = 7 * MiB;
constexpr size_t WS_W = 25 * MiB;
constexpr size_t W_IN_SZ = (size_t)NPROJP * DM * 2, W_UQ_SZ = (size_t)NQB * 512 * 2, W_UKV_SZ = (size_t)NKVB * 256 * 2, W_O_SZ = (size_t)DM * DM * 2,
                 W_SCIN_SZ = (size_t)NSC * DM * 2, W_SCOUT_SZ = (size_t)DM * DM * 2, W_UP_SZ = (size_t)NUP * DM * 2, W_DN_SZ = (size_t)DM * DFF * 2;
constexpr size_t WS_W_IN = WS_W, WS_W_SCIN = WS_W_IN + 2 * W_IN_SZ, WS_W_UP = WS_W_SCIN + 2 * W_SCIN_SZ, WS_W_UQ = WS_W_UP + 4 * W_UP_SZ, WS_W_UKV = WS_W_UQ + 2 * W_UQ_SZ,
                 WS_W_O = WS_W_UKV + 2 * W_UKV_SZ, WS_W_SCOUT = WS_W_O + 2 * W_O_SZ, WS_W_DN = WS_W_SCOUT + 2 * W_SCOUT_SZ, WS_W_END = WS_W_DN + 4 * W_DN_SZ;
constexpr int SB_COL_IN = 0, SB_COL_SCIN = 2 * NPROJP, SB_COL_UP = 2 * NPROJP + 2 * NSC;
static_assert(WS_W_END == 394 * MiB && WS_W_UQ - WS_W == (size_t)pg8::SB_LD * DM * 2 && SB_COL_UP + 4 * NUP == pg8::SB_LD, "weight copies end at 394 MiB; SB GEMM view");
static_assert(WS_WEFF + 4 * 2 * 9 * DM * 4 <= WS_SHIFT && WS_SS + (size_t)MR * 8 * 4 <= WS_SB && WS_SB + (size_t)72 * pg8::SB_LD * 4 <= WS_W, "low d_ws map");
constexpr size_t WS_X = 394 * MiB;
constexpr size_t WS_H = WS_X + (size_t)MR * DM * 2;
constexpr size_t WS_O = WS_H + (size_t)MR * DM * 2;
constexpr size_t WS_S = WS_O + (size_t)MR * DM * 2;
static_assert(WS_S == 802 * MiB, "scratch starts at 802 MiB");
constexpr size_t WS_PROJ = WS_S, WS_QA = WS_PROJ + (size_t)MR * NPROJP * 2, WS_KA = WS_QA + (size_t)MR * 1024 * 2, WS_CQ = WS_KA + (size_t)MR * 256 * 2,
                 WS_CKV = WS_CQ + (size_t)MR * 512 * 2, WS_KR = WS_CKV + (size_t)MR * 256 * 2, WS_QB = WS_KR + 5 * MiB, WS_KVB = WS_QB + (size_t)MR * NQB * 2,
                 WS_ATT_END = WS_KVB + (size_t)MR * NKVB * 2;
constexpr size_t WS_SCP = WS_S;
constexpr size_t WS_BB = WS_S, WS_SCHALO = WS_BB + (size_t)MR * DM * 2;
constexpr size_t WS_ACT = WS_S, WS_HALO = WS_ACT + (size_t)MR * DFF * 2, WS_FFN_END = WS_HALO + (size_t)NTM * 4 * 2 * DFF * 4;
constexpr size_t WS_PART = WS_S;
constexpr size_t WS_END = 1536 * MiB;
constexpr size_t WS_SLAB = WS_END - 64 * MiB;
static_assert(WS_ATT_END <= WS_SLAB && WS_SCP + (size_t)MR * NSC * 2 <= WS_SLAB && WS_FFN_END <= WS_SLAB && WS_SCP + (size_t)MR * NSC * 2 <= WS_END && WS_FFN_END <= WS_END && WS_PART + (size_t)16 * 4 * 9 * MODW * 4 <= WS_END, "d_ws map");

constexpr int RING_OFF = 0, RING_BYTES = 131072;
constexpr int XTRA_OFF = RING_BYTES, XTRA_BYTES = 24576;
constexpr int LDSCTL_OFF = XTRA_OFF + XTRA_BYTES, MISC_OFF = LDSCTL_OFF + 320;
constexpr int LDS_BYTES = LDSCTL_OFF + 1024;
static_assert(MISC_OFF + 128 <= LDS_BYTES && LDS_BYTES <= 163840, "LDS map");

#define GAS __attribute__((address_space(1)))
#define LAS __attribute__((address_space(3)))
typedef unsigned short bf16;
typedef unsigned v4u __attribute__((ext_vector_type(4)));
typedef unsigned v2u __attribute__((ext_vector_type(2)));
typedef float f32x4 __attribute__((ext_vector_type(4)));
typedef GAS unsigned gu32;
#define RLX_AGENT __ATOMIC_RELAXED, __HIP_MEMORY_SCOPE_AGENT
#define LDS_WAIT() asm volatile("s_waitcnt lgkmcnt(0)" ::: "memory")
#define VM_WAIT() asm volatile("s_waitcnt vmcnt(0)" ::: "memory")
__device__ __forceinline__ unsigned pk2(float lo, float hi) { return pg8::cvt_pk_bf16(lo, hi); }
__device__ __forceinline__ float bflo(unsigned w) { return __uint_as_float(w << 16); }
__device__ __forceinline__ float bfhi(unsigned w) { return __uint_as_float(w & 0xffff0000u); }
__device__ __forceinline__ float bf1(bf16 h) { return __uint_as_float((unsigned)h << 16); }
#define XB_TMO      128
#define XB_XCNT(j)  (256  + 64 * (j))
#define XB_XSUB(j)  (1280 + 64 * (j))
#define XB_XGEN(j)  (2304 + 64 * (j))
#define XB_TOP      3328
#define XB_TOPGEN   3392
#define XCD_BAR_WORDS 3456
#define XB_SPIN_CAP (1u << 18)
#define LAS_GLOBAL __attribute__((address_space(1)))

__device__ __forceinline__ unsigned xb_ld(unsigned* p)              { return __hip_atomic_load((LAS_GLOBAL unsigned*)p, __ATOMIC_RELAXED, __HIP_MEMORY_SCOPE_AGENT); }
__device__ __forceinline__ unsigned xb_add(unsigned* p, unsigned v) { return __hip_atomic_fetch_add((LAS_GLOBAL unsigned*)p, v, __ATOMIC_RELAXED, __HIP_MEMORY_SCOPE_AGENT); }
__device__ __forceinline__ unsigned xb_xcc_id() { return (unsigned)__builtin_amdgcn_s_getreg((3 << 11) | 20) & 0xFu; }
#define XB_SPIN(cond, bar) do { unsigned _sp = 0; while (cond) { __builtin_amdgcn_s_sleep(1); \
    if ((++_sp & 255u) == 0u) { if (xb_ld(&(bar)[XB_TMO])) break; if (_sp > XB_SPIN_CAP) { xb_add(&(bar)[XB_TMO], 1u); break; } } } } while (0)

struct XcdBarrier {
    unsigned* bar; unsigned x;
    volatile LAS unsigned* st;
};

__device__ __forceinline__ XcdBarrier xcd_barrier_post(unsigned* bar, volatile LAS unsigned* st) {
    XcdBarrier b; b.bar = bar; b.x = xb_xcc_id(); b.st = st;
    if (threadIdx.x == 0) (void)xb_add(&bar[XB_XCNT(b.x)], 1u);
    return b;
}
__device__ __forceinline__ void xcd_barrier_complete(unsigned* bar, unsigned x, unsigned& nloc, unsigned& nx) {
    const unsigned G = gridDim.x * gridDim.y * gridDim.z;
    unsigned sum, cnt, mine, sp = 0u;
    for (;;) {
        sum = 0u; cnt = 0u; mine = 0u;
#pragma unroll
        for (unsigned j = 0; j < 16; ++j) { const unsigned c = xb_ld(&bar[XB_XCNT(j)]); sum += c; cnt += (c > 0u) ? 1u : 0u; mine = (j == x) ? c : mine; }
        if (sum == G) break;
        __builtin_amdgcn_s_sleep(1);
        if ((++sp & 255u) == 0u) { if (xb_ld(&bar[XB_TMO])) break; if (sp > XB_SPIN_CAP) { xb_add(&bar[XB_TMO], 1u); break; } }
    }
    nloc = mine > 0u ? mine : 1u; nx = cnt > 0u ? cnt : 1u;
}

__device__ __forceinline__ void xcd_barrier(const XcdBarrier& b, const bool t0  ) {
    asm volatile("s_waitcnt vmcnt(0)" ::: "memory");
    __syncthreads();
    if (t0) {
        unsigned* bar = b.bar;
        __builtin_amdgcn_s_waitcnt(0);
        unsigned nloc = b.st[0], nx = b.st[1];
        if (nloc == 0u) { xcd_barrier_complete(bar, b.x, nloc, nx); b.st[0] = nloc; b.st[1] = nx; }
        const unsigned old = xb_add(&bar[XB_XSUB(b.x)], 1u);
        const unsigned gen = old / nloc;
        if (old + 1u == (gen + 1u) * nloc) {
            __builtin_amdgcn_fence(__ATOMIC_RELEASE, "agent");
            asm volatile("s_waitcnt vmcnt(0)" ::: "memory");
            const unsigned og = xb_add(&bar[XB_TOP], 1u);
            const unsigned tg = og / nx;
            if (og + 1u == (tg + 1u) * nx) xb_add(&bar[XB_TOPGEN], 1u);
            else XB_SPIN(xb_ld(&bar[XB_TOPGEN]) == tg, bar);
            __builtin_amdgcn_fence(__ATOMIC_ACQUIRE, "agent");
            xb_add(&bar[XB_XGEN(b.x)], 1u);
            asm volatile("s_waitcnt vmcnt(0)" ::: "memory");
        } else {
            XB_SPIN(xb_ld(&bar[XB_XGEN(b.x)]) == gen, bar);
            __builtin_amdgcn_fence(__ATOMIC_ACQUIRE, "agent");
            asm volatile("s_waitcnt vmcnt(0)" ::: "memory");
        }
    }
    __syncthreads();
}

__device__ __forceinline__ float wave_sum(float v) {
#pragma unroll
    for (int o = 1; o < 64; o <<= 1) v += __shfl_xor(v, o);
    return v;
}
__device__ __forceinline__ void p0_transpose_item(const float* W, int K, int N, bf16* WT, LAS float* scr, int item, int lane, int permmode) {
    const int nblk = N / 64, kb = item / nblk, nb = item % nblk, k0 = 64 * kb, n0 = 64 * nb;
    int d0 = n0; if (permmode == 1) { const int gu = n0 >= DFF ? 1 : 0, j = n0 - gu * DFF; d0 = (j >> 7) * 256 + gu * 128 + (j & 127); }
    if (permmode == 2) { const int seg = n0 >> 11, j = n0 & 2047, q = j >> 8, r = j & 255; d0 = seg == 0 ? 768 * q + r : 768 * q + 256 + (r >> 7) * 256 + (seg == 2 ? 128 : 0) + (r & 127); }
    const int kr = lane >> 4, nc = (lane & 15) * 4;
    const GAS f32x4* src = (const GAS f32x4*)(W + (size_t)(k0 + kr) * N + n0 + nc);
    f32x4 v[16];
#pragma unroll
    for (int i = 0; i < 16; ++i) v[i] = __builtin_nontemporal_load(src + (size_t)i * N);
#pragma unroll
    for (int i = 0; i < 16; ++i) { LAS float* d = scr + (4 * i + kr) * 65 + nc; d[0] = v[i].x; d[1] = v[i].y; d[2] = v[i].z; d[3] = v[i].w; }
    LDS_WAIT(); asm volatile("" ::: "memory");
    const int c = lane & 7;
#pragma unroll
    for (int j = 0; j < 8; ++j) { const int n = (lane >> 3) + 8 * j; const LAS float* s = scr + (8 * c) * 65 + n;
        v4u o; o.x = pk2(s[0 * 65], s[1 * 65]); o.y = pk2(s[2 * 65], s[3 * 65]); o.z = pk2(s[4 * 65], s[5 * 65]); o.w = pk2(s[6 * 65], s[7 * 65]);
        *(GAS v4u*)(WT + (size_t)(d0 + n) * K + k0 + 8 * c) = o; }
    LDS_WAIT(); asm volatile("" ::: "memory");
}
__device__ __forceinline__ void sincos_d(double a, double& s, double& c) {
    const double TWO_PI = 6.283185307179586476925286766559;
    const double k = __builtin_rint(a * (1.0 / TWO_PI)); const double r = a - k * TWO_PI, r2 = r * r;
    double ts = r, tc = 1.0; s = r; c = 1.0;
#pragma unroll
    for (int n = 1; n <= 16; ++n) { tc = -tc * r2 / (double)((2 * n - 1) * (2 * n)); ts = -ts * r2 / (double)((2 * n) * (2 * n + 1)); c += tc; s += ts; }
}

struct Args { const float* in[23]; float* out; unsigned char* ws; int ph_lo, ph_hi; };
typedef const Args __attribute__((address_space(4)))* KAp;
__device__ __forceinline__ KAp kargs() { KAp p = (KAp)__builtin_amdgcn_kernarg_segment_ptr(); asm volatile("" : "+s"(p)); return p; }
struct TI { int tid, lane, wave, G, bx, vcu, gw, NGW; };
__device__ __forceinline__ TI thread_info(const int wv) {
    TI t; int tid = wv * 64 + pg8::lane_id_l(); asm volatile("" : "+v"(tid)); int bx = blockIdx.x; asm volatile("" : "+s"(bx)); int G = gridDim.x; asm volatile("" : "+s"(G));
    t.tid = tid; t.lane = tid & 63; t.wave = __builtin_amdgcn_readfirstlane(tid >> 6); t.G = G; t.bx = bx;
    t.vcu = (G % 8 == 0) ? (bx % 8) * (G / 8) + bx / 8 : bx; t.gw = t.vcu * NWAVES + t.wave; t.NGW = G * NWAVES; return t;
}
#define A_X(ka)        ((ka)->in[0])
#define A_C(ka)        ((ka)->in[1])
#define A_CTX(ka)      ((ka)->in[2])
#define A_CCTX(ka)     ((ka)->in[3])
#define A_WADA(ka)     ((ka)->in[4])
#define A_BADA(ka)     ((ka)->in[5])
#define A_NMIX(ka)     ((ka)->in[6])
#define A_NFFN(ka)     ((ka)->in[7])
#define A_WIN(ka)      ((ka)->in[8])
#define A_QNORM(ka)    ((ka)->in[9])
#define A_KNORM(ka)    ((ka)->in[10])
#define A_MQNORM(ka)   ((ka)->in[11])
#define A_MKVNORM(ka)  ((ka)->in[12])
#define A_WUQ(ka)      ((ka)->in[13])
#define A_WUKV(ka)     ((ka)->in[14])
#define A_WO(ka)       ((ka)->in[15])
#define A_SCWIN(ka)    ((ka)->in[16])
#define A_SCCONV(ka)   ((ka)->in[17])
#define A_SCWOUT(ka)   ((ka)->in[18])
#define A_FUP(ka)      ((ka)->in[19])
#define A_FCONV(ka)    ((ka)->in[20])
#define A_FDOWN(ka)    ((ka)->in[21])
#define A_FNORM(ka)    ((ka)->in[22])

constexpr int I_IN = 32 * 37, I_UQ = 8 * 24, I_UKV = 4 * 32, I_O = 32 * 32, I_SCIN = 32 * 96, I_SCOUT = 32 * 32, I_UP = 32 * 176, I_DN = 88 * 32;
constexpr int N_TR_EARLY = 2 * (I_IN + I_SCIN) + 4 * I_UP, N_TR_LATE = I_UQ + I_UKV + I_O + 2 * I_SCOUT + 3 * I_DN;
template <bool LATE>
__device__ __forceinline__ void tr_item(KAp ka, unsigned char* ws, LAS float* scr, int r, int lane) {
    const float* src = nullptr; bf16* dst = nullptr; int K = 0, N = 0; bool found = false; int permmode = 0;
#define SEL(SRC, KK, NN, CNT, DST) if (!found) { if (r < (CNT)) { src = (SRC); K = (KK); N = (NN); dst = (bf16*)(DST); found = true; } else r -= (CNT); }
#pragma unroll
    for (int i = 0; i < 2; ++i) {
        if (!LATE) { SEL(A_WIN(ka) + (size_t)i * DM * NPROJ, DM, NPROJ, I_IN, ws + WS_W_IN + i * W_IN_SZ) }
        if (LATE && i == 1) {
            SEL(A_WUQ(ka) + (size_t)i * 512 * NQB, 512, NQB, I_UQ, ws + WS_W_UQ + i * W_UQ_SZ)
            SEL(A_WUKV(ka) + (size_t)i * 256 * NKVB, 256, NKVB, I_UKV, ws + WS_W_UKV + i * W_UKV_SZ)
            SEL(A_WO(ka) + (size_t)i * DM * DM, DM, DM, I_O, ws + WS_W_O + i * W_O_SZ) }
        if (!LATE) { SEL(A_SCWIN(ka) + (size_t)i * DM * NSC, DM, NSC, I_SCIN, ws + WS_W_SCIN + i * W_SCIN_SZ) if (found && N == NSC) permmode = 2; }
        if (LATE) { SEL(A_SCWOUT(ka) + (size_t)i * DM * DM, DM, DM, I_SCOUT, ws + WS_W_SCOUT + i * W_SCOUT_SZ) }
    }
#pragma unroll
    for (int i = 0; i < 4; ++i) {
        if (!LATE) { SEL(A_FUP(ka) + (size_t)i * DM * NUP, DM, NUP, I_UP, ws + WS_W_UP + i * W_UP_SZ) if (found && N == NUP) permmode = 1; }
        if (LATE && i >= 1) { SEL(A_FDOWN(ka) + (size_t)i * DFF * DM, DFF, DM, I_DN, ws + WS_W_DN + i * W_DN_SZ) }
    }
#undef SEL
    if (found) p0_transpose_item(src, K, N, dst, scr, r, lane, permmode);
}
__device__ __forceinline__ void ph_dn0_tr(KAp ka, LAS unsigned char* lds, const int wv, int idx, int cnt) {
    const TI t = thread_info(wv);
    LAS float* scr = (LAS float*)(lds + RING_OFF + t.wave * 16640);
    for (int it = idx * NWAVES + t.wave; it < I_DN; it += cnt * NWAVES) p0_transpose_item(A_FDOWN(ka), DFF, DM, (bf16*)(ka->ws + WS_W_DN), scr, it, t.lane, 0);
}
__device__ __forceinline__ void ph_att0_tr(KAp ka, LAS unsigned char* lds, const int wv, int idx, int cnt) {
    const TI t = thread_info(wv);
    LAS float* scr = (LAS float*)(lds + RING_OFF + t.wave * 16640);
    for (int it = idx * NWAVES + t.wave; it < I_UQ + I_UKV + I_O; it += cnt * NWAVES) {
        if (it < I_UQ) p0_transpose_item(A_WUQ(ka), 512, NQB, (bf16*)(ka->ws + WS_W_UQ), scr, it, t.lane, 0);
        else if (it < I_UQ + I_UKV) p0_transpose_item(A_WUKV(ka), 256, NKVB, (bf16*)(ka->ws + WS_W_UKV), scr, it - I_UQ, t.lane, 0);
        else p0_transpose_item(A_WO(ka), DM, DM, (bf16*)(ka->ws + WS_W_O), scr, it - I_UQ - I_UKV, t.lane, 0);
    }
}
__device__ __forceinline__ void ph_late_tr(KAp ka, LAS unsigned char* lds, const int wv, int idx, int cnt) {
    const TI t = thread_info(wv);
    LAS float* scr = (LAS float*)(lds + RING_OFF + t.wave * 16640);
    for (int it = idx * NWAVES + t.wave; it < N_TR_LATE; it += cnt * NWAVES) tr_item<true>(ka, ka->ws, scr, it, t.lane);
}
__device__ __forceinline__ void ph_prologue(KAp ka, LAS unsigned char* lds, const int wv) {
    const TI t = thread_info(wv); const int gw = t.gw, NGW = t.NGW, wave = t.wave, lane = t.lane, vcu = t.vcu;
    LAS float* scr = (LAS float*)(lds + RING_OFF + wave * 16640);
    unsigned char* ws = (ka)->ws;
    constexpr int N_ADA = 4 * 48 * 16;
    for (int it = gw; it < N_ADA; it += NGW) {
        {
            const int kc = it & 15, cc = (it >> 4) % 48, l = it / 768, n0 = cc * 256 + lane * 4;
            f32x4 acc[9];
#pragma unroll
            for (int b = 0; b < 9; ++b) acc[b] = (f32x4){0.f, 0.f, 0.f, 0.f};
            const float* wp = A_WADA(ka) + ((size_t)l * DM + kc * 128) * MODW + n0;
            for (int half = 0; half < 2; ++half) {
                const int kb = kc * 128 + half * 64;
                float sv[9];
#pragma unroll
                for (int b = 0; b < 9; ++b) { const float xv = (b < 8) ? A_C(ka)[b * DM + kb + lane] : A_CCTX(ka)[kb + lane]; sv[b] = xv / (1.f + __expf(-xv)); }
#pragma unroll 16
                for (int kk = 0; kk < 64; ++kk) {
                    const f32x4 w = __builtin_nontemporal_load((const f32x4*)(wp + (size_t)(half * 64 + kk) * MODW));
#pragma unroll
                    for (int b = 0; b < 9; ++b) { const float s = __int_as_float(__builtin_amdgcn_readlane(__float_as_int(sv[b]), kk)); acc[b] += s * w; }
                }
            }
            float* part = (float*)(ws + WS_PART) + ((size_t)(kc * 4 + l) * 9) * MODW + n0;
#pragma unroll
            for (int b = 0; b < 9; ++b) *(f32x4*)(part + (size_t)b * MODW) = acc[b];
        }
    }
    {   const int amin = N_ADA / NGW, H = N_ADA - amin * NGW, Lc = NGW - H;
        const int PL = (H > 0) ? (Lc * 5 < N_TR_EARLY ? Lc * 5 : N_TR_EARLY) : 0;
        const int nL = (gw >= H && gw - H < PL) ? (PL - (gw - H) + Lc - 1) / Lc : 0;
        for (int j = 0; ; ++j) { const int it = j < nL ? (gw - H) + j * Lc : PL + gw + (j - nL) * NGW; if (it >= N_TR_EARLY) break; tr_item<false>(ka, ws, scr, it, lane); } }
    if (vcu == 0) {
        float* tabA = (float*)(ws + WS_TAB); float* tabB = (float*)(ws + WS_TAB + 16384);
        for (int e = wave * 64 + lane; e < 64 * 48; e += NWAVES * 64) {
            const int p = e / 48, q = e % 48; const bool isA = q < 32; const int i = isA ? q : q - 32;
            const float inv = (float)exp2(-(double)i / (isA ? 32.0 : 16.0) * 13.287712379549449);
            const float ang = (float)p * inv; double s, c; sincos_d((double)ang, s, c);
            float* t = isA ? tabA + (p * 32 + i) * 2 : tabB + (p * 16 + i) * 2; t[0] = (float)c; t[1] = (float)s;
        }
    }
}
__device__ __forceinline__ void ph_modfin(KAp ka, const int wv) {
    const TI t = thread_info(wv); const int gtid = t.gw * 64 + t.lane, NGT = t.NGW * 64;
    const float* part = (const float*)((ka)->ws + WS_PART); float* mod = (float*)((ka)->ws + WS_MOD);
    bf16* SHIFT = (bf16*)((ka)->ws + WS_SHIFT); float* WEFF = (float*)((ka)->ws + WS_WEFF);
    for (int e = gtid; e < 4 * 9 * MODW / 4; e += NGT) {
        const int n4 = e % (MODW / 4), lb = e / (MODW / 4), l = lb / 9, bb = lb - l * 9;
        f32x4 a = *(const f32x4*)(A_BADA(ka) + (size_t)l * MODW + n4 * 4);
#pragma unroll
        for (int kc = 0; kc < 16; ++kc) a += *(const f32x4*)(part + ((size_t)(kc * 4 + l) * 9 + bb) * MODW + n4 * 4);
        *(f32x4*)(mod + (size_t)lb * MODW + n4 * 4) = a;
        const int seg = (n4 * 4) / DM, col = (n4 * 4) % DM;
        if (seg == 0 || seg == 3) { v2u w; w.x = pk2(a[0], a[1]); w.y = pk2(a[2], a[3]); *(v2u*)(SHIFT + ((size_t)((l * 2 + (seg == 3)) * 9 + bb)) * DM + col) = w; }
        if (seg == 1 || seg == 4) { const f32x4 nw = *(const f32x4*)((seg == 4 ? A_NFFN(ka) : A_NMIX(ka)) + (size_t)l * DM + col);
            *(f32x4*)(WEFF + ((size_t)((l * 2 + (seg == 4)) * 9 + bb)) * DM + col) = nw * (a + 1.0f); }
    }
}
__device__ __forceinline__ void ph_xinit(KAp ka, const int wv, const int nsb  ) {
    const TI t = thread_info(wv); const int gw = t.gw, NGW = t.NGW, lane = t.lane;
    bf16* X = (bf16*)(ka->ws + WS_X); bf16* H = (bf16*)(ka->ws + WS_H); float* SS = (float*)(ka->ws + WS_SS); const float* WEFF = (const float*)(ka->ws + WS_WEFF);
    constexpr int XI_EXTRA = 8;
    const int nfree = t.G - nsb, LA = nfree * NWAVES, RA = (nsb > 0 && nfree > 0) ? LA * XI_EXTRA : 0;
    const int rankA = (t.bx - nsb) * NWAVES + t.wave, nA = (t.bx >= nsb && RA > 0) ? XI_EXTRA : 0;
#define XI_ROW(j) ((j) < nA ? rankA + (j) * LA : RA + gw + ((j) - nA) * NGW)
    for (int jj = 0; XI_ROW(jj) < MR; jj += 2) {
        const int r0 = XI_ROW(jj), r1_ = XI_ROW(jj + 1);
        f32x4 v[2][8]; bool val[2]; int bidx[2];
#pragma unroll
        for (int q = 0; q < 2; ++q) { const int r = q ? r1_ : r0; val[q] = r < MR; const int ru = val[q] ? r : r0;
            const int b = ru / TPB, tt = ru % TPB; bidx[q] = (tt < CTXL) ? 8 : b;
            const float* srow = (tt < CTXL) ? A_CTX(ka) + ((size_t)b * CTXL + tt) * DM : A_X(ka) + ((size_t)b * SEQ + (tt - CTXL)) * DM;
            const GAS f32x4* s4 = (const GAS f32x4*)srow + lane;
#pragma unroll
            for (int j = 0; j < 8; ++j) v[q][j] = s4[64 * j]; }
#pragma unroll
        for (int q = 0; q < 2; ++q) { if (!val[q]) continue;
            const int r = q ? r1_ : r0;
            GAS v2u* d8 = (GAS v2u*)(X + (size_t)r * DM) + lane; GAS v2u* o8 = (GAS v2u*)(H + (size_t)r * DM) + lane;
            const float* wf = WEFF + (size_t)bidx[q] * DM;
            float ss = 0.f;
#pragma unroll
            for (int j = 0; j < 8; ++j) { const f32x4 x = v[q][j]; v2u xo; xo.x = pk2(x.x, x.y); xo.y = pk2(x.z, x.w); d8[64 * j] = xo; ss += (x.x * x.x + x.y * x.y) + (x.z * x.z + x.w * x.w);
                const f32x4 y = x * *(const f32x4*)(wf + 4 * lane + 256 * j); v2u o; o.x = pk2(y.x, y.y); o.y = pk2(y.z, y.w); o8[64 * j] = o; }
            ss = wave_sum(ss);
            if (lane == 0) { float z_ = 0.f; asm volatile("" : "+v"(z_));
                *(f32x4*)(SS + (size_t)r * 8) = (f32x4){ss, z_, z_, z_}; *(f32x4*)(SS + (size_t)r * 8 + 4) = (f32x4){z_, z_, z_, z_}; } }
    }
}
__device__ __forceinline__ void ph_ctx_combine(KAp ka, const float* gate8  , const float* weff8, bool donorm, const int wv) {
    const TI t = thread_info(wv); const int gw = t.gw, NGW = t.NGW, lane = t.lane;
    bf16* X = (bf16*)(ka->ws + WS_X); bf16* H = (bf16*)(ka->ws + WS_H); float* SS = (float*)(ka->ws + WS_SS); const float* slab = (const float*)(ka->ws + WS_SLAB);
    for (int rc = gw; rc < NB * CTXL; rc += NGW) {
        const int r = (rc >> 8) * TPB + (rc & 255);
        GAS v2u* xp = (GAS v2u*)(X + (size_t)r * DM) + lane; GAS v2u* hp = (GAS v2u*)(H + (size_t)r * DM) + lane;
        float ss = 0.f;
#pragma unroll
        for (int j = 0; j < 8; ++j) { const int col = 4 * lane + 256 * j;
            f32x4 a = *(const f32x4*)(slab + (size_t)rc * DM + col);
#pragma unroll
            for (int s = 1; s < 4; ++s) a += *(const f32x4*)(slab + ((size_t)s * (NB * CTXL) + rc) * DM + col);
            const v2u xw = xp[64 * j]; f32x4 x = (f32x4){bflo(xw.x), bfhi(xw.x), bflo(xw.y), bfhi(xw.y)};
            x = x + *(const f32x4*)(gate8 + col) * a;
            v2u xo; xo.x = pk2(x.x, x.y); xo.y = pk2(x.z, x.w); xp[64 * j] = xo;
            if (donorm) { ss += (x.x * x.x + x.y * x.y) + (x.z * x.z + x.w * x.w); const f32x4 y = x * *(const f32x4*)(weff8 + col); v2u o; o.x = pk2(y.x, y.y); o.y = pk2(y.z, y.w); hp[64 * j] = o; }
        }
        if (donorm) { ss = wave_sum(ss); if (lane == 0) { float z_ = 0.f; asm volatile("" : "+v"(z_));
            *(f32x4*)(SS + (size_t)r * 8) = (f32x4){ss, z_, z_, z_}; *(f32x4*)(SS + (size_t)r * 8 + 4) = (f32x4){z_, z_, z_, z_}; } }
    }
}
__device__ __forceinline__ void ph_final(KAp ka, const int wv) {
    const TI t = thread_info(wv); const int gw = t.gw, NGW = t.NGW, lane = t.lane;
    const bf16* X = (const bf16*)((ka)->ws + WS_X);
    constexpr int NQ = 4;
    for (int rr0 = gw; rr0 < NB * SEQ; rr0 += NQ * NGW) {
        v4u w[NQ][4]; bool val[NQ];
#pragma unroll
        for (int q = 0; q < NQ; ++q) { const int rr = rr0 + q * NGW; val[q] = rr < NB * SEQ; const int ru = val[q] ? rr : rr0;
            const int r = (ru >> 12) * TPB + CTXL + (ru & 4095); const GAS v4u* xr = (const GAS v4u*)(X + (size_t)r * DM) + lane;
#pragma unroll
            for (int j = 0; j < 4; ++j) w[q][j] = xr[64 * j]; }
#pragma unroll
        for (int q = 0; q < NQ; ++q) { if (!val[q]) continue;
            f32x4 v[4][2]; float ss = 0.f;
#pragma unroll
            for (int j = 0; j < 4; ++j) { v[j][0] = (f32x4){bflo(w[q][j].x), bfhi(w[q][j].x), bflo(w[q][j].y), bfhi(w[q][j].y)}; v[j][1] = (f32x4){bflo(w[q][j].z), bfhi(w[q][j].z), bflo(w[q][j].w), bfhi(w[q][j].w)};
                ss += ((v[j][0].x * v[j][0].x + v[j][0].y * v[j][0].y) + (v[j][0].z * v[j][0].z + v[j][0].w * v[j][0].w)) + ((v[j][1].x * v[j][1].x + v[j][1].y * v[j][1].y) + (v[j][1].z * v[j][1].z + v[j][1].w * v[j][1].w)); }
            const float rstd = 1.0f / sqrtf(wave_sum(ss) * (1.f / DM) + EPS);
            GAS f32x4* o4 = (GAS f32x4*)((ka)->out + (size_t)(rr0 + q * NGW) * DM) + 2 * lane;
#pragma unroll
            for (int j = 0; j < 4; ++j) { const float* wp = A_FNORM(ka) + 8 * lane + 512 * j;
                o4[128 * j] = (v[j][0] * rstd) * *(const f32x4*)wp; o4[128 * j + 1] = (v[j][1] * rstd) * *(const f32x4*)(wp + 4); } }
    }
}
__device__ __forceinline__ void ph_attn_post(KAp ka, int i, const int wv) {
    const TI t = thread_info(wv); const int gw = t.gw, NGW = t.NGW, lane = t.lane;
    unsigned char* ws = (ka)->ws;
    const bf16* PROJ = (const bf16*)(ws + WS_PROJ); bf16* QA = (bf16*)(ws + WS_QA); bf16* KA = (bf16*)(ws + WS_KA); bf16* CQ = (bf16*)(ws + WS_CQ);
    bf16* CKV = (bf16*)(ws + WS_CKV); bf16* KR = (bf16*)(ws + WS_KR);
    const float* tabA = (const float*)(ws + WS_TAB); const float* tabB = (const float*)(ws + WS_TAB + 16384);
    const float* qn = A_QNORM(ka) + i * 128; const float* kn = A_KNORM(ka) + i * 128; const float* qnb = A_MQNORM(ka) + i * 512; const float* kvn = A_MKVNORM(ka) + i * 256;
    const float qw0 = qn[2 * lane], qw1 = qn[2 * lane + 1], kw0 = kn[2 * lane], kw1 = kn[2 * lane + 1];
    const bool odd = (lane >> 4) & 1; const float sgn = odd ? 1.f : -1.f;
    const f32x4 g0q = *(const f32x4*)(qnb + 8 * lane), g1q = *(const f32x4*)(qnb + 8 * lane + 4), gkv = *(const f32x4*)(kvn + 4 * lane);
    constexpr int NQ = 4;
    for (int r0 = gw; r0 < MR; r0 += NQ * NGW) {
        unsigned wh[NQ][10]; v4u wq[NQ]; v2u wkv[NQ]; bf16 wkr[NQ]; f32x4 csA[NQ]; float cB[NQ], sB[NQ]; bool val[NQ];
#pragma unroll
        for (int q = 0; q < NQ; ++q) {
            const int r = r0 + q * NGW; val[q] = r < MR; const int rr = val[q] ? r : r0;
            const int tt = rr % TPB; const bool isctx = tt < CTXL; const int tp = tt - CTXL, pos = (lane < 32) ? (tp >> 6) : (tp & 63);
            const bf16* pr = PROJ + (size_t)rr * NPROJP;
#pragma unroll
            for (int h = 8; h < 10; ++h) wh[q][h] = *(const unsigned*)(pr + 1024 + (h - 8) * 128 + 2 * lane);
            wq[q] = *(const v4u*)(pr + 1536 + 8 * lane); wkv[q] = *(const v2u*)(pr + 2048 + 4 * lane); wkr[q] = pr[2304 + lane];
            csA[q] = (f32x4){1.f, 0.f, 1.f, 0.f}; cB[q] = 1.f; sB[q] = 0.f;
            if (!isctx) { csA[q] = *(const f32x4*)(tabA + (pos * 32 + 2 * (lane & 15)) * 2); cB[q] = tabB[(pos * 16 + (lane & 15)) * 2]; sB[q] = tabB[(pos * 16 + (lane & 15)) * 2 + 1]; }
        }
#pragma unroll
        for (int q = 0; q < NQ; ++q) {
            if (!val[q]) continue;
            const int r = r0 + q * NGW;
#pragma unroll
            for (int h = 8; h < 10; ++h) {
                const unsigned w = wh[q][h];
                float x0 = bflo(w), x1 = bfhi(w);
                const float rstd = 1.0f / sqrtf(wave_sum(x0 * x0 + x1 * x1) * (1.f / 128.f) + EPS);
                x0 = x0 * rstd * (h < 8 ? qw0 : kw0); x1 = x1 * rstd * (h < 8 ? qw1 : kw1);
                const float p0 = __shfl_xor(x0, 16), p1 = __shfl_xor(x1, 16);
                const float y0 = x0 * csA[q].x + sgn * p0 * csA[q].y, y1 = x1 * csA[q].z + sgn * p1 * csA[q].w;
                bf16* dst = (h < 8) ? QA + (size_t)r * 1024 + h * 128 : KA + (size_t)r * 256 + (h - 8) * 128;
                *(unsigned*)(dst + 2 * lane) = pk2(y0, y1);
            }
            { const v4u w = wq[q];
              float x[8] = {bflo(w.x), bfhi(w.x), bflo(w.y), bfhi(w.y), bflo(w.z), bfhi(w.z), bflo(w.w), bfhi(w.w)}; float ss = 0.f;
#pragma unroll
              for (int e = 0; e < 8; ++e) ss += x[e] * x[e];
              const float rstd = 1.0f / sqrtf(wave_sum(ss) * (1.f / 512.f) + EPS);
              v4u o; o.x = pk2(x[0] * rstd * g0q.x, x[1] * rstd * g0q.y); o.y = pk2(x[2] * rstd * g0q.z, x[3] * rstd * g0q.w);
              o.z = pk2(x[4] * rstd * g1q.x, x[5] * rstd * g1q.y); o.w = pk2(x[6] * rstd * g1q.z, x[7] * rstd * g1q.w);
              *(v4u*)(CQ + (size_t)r * 512 + 8 * lane) = o; }
            { const v2u w = wkv[q];
              const float x0 = bflo(w.x), x1 = bfhi(w.x), x2 = bflo(w.y), x3 = bfhi(w.y);
              const float rstd = 1.0f / sqrtf(wave_sum((x0 * x0 + x1 * x1) + (x2 * x2 + x3 * x3)) * (1.f / 256.f) + EPS);
              v2u o; o.x = pk2(x0 * rstd * gkv.x, x1 * rstd * gkv.y); o.y = pk2(x2 * rstd * gkv.z, x3 * rstd * gkv.w);
              *(v2u*)(CKV + (size_t)r * 256 + 4 * lane) = o; }
            { const float xk = bf1(wkr[q]); const float pk = __shfl_xor(xk, 16);
              const float y = xk * cB[q] + sgn * pk * sB[q];
              KR[(size_t)r * 64 + lane] = (bf16)(pk2(y, 0.f) & 0xffffu); }
        }
    }
}
__device__ __forceinline__ void ph_ffn_fix(KAp ka, int l, bool latent, const int wv) {
    const TI t = thread_info(wv); const int gw = t.gw, NGW = t.NGW, lane = t.lane;
    const GAS float* HALO = (const GAS float*)(ka->ws + WS_HALO); bf16* ACT = (bf16*)(ka->ws + WS_ACT); const GAS float* cw = (const GAS float*)(A_FCONV(ka) + (size_t)l * 3 * NUP);
    const int ntile = latent ? 128 : NTM, nitems = ntile * 2 * 22;
    for (int it = gw; it < nitems; it += NGW) {
        const int ch = it % 22, edge = (it / 22) & 1, tv = it / 44, pm = latent ? tv + (tv >> 4) + 1 : tv, t17 = pm % 17;
        const int col = ch * 256 + lane * 4;
        const GAS float* hrow[3]; bool zero0 = false, zero2 = false;
        if (edge == 0) { zero0 = (t17 == 0 || t17 == 1); hrow[0] = HALO + ((size_t)((pm - 1) * 4 + 3) * 2) * DFF; hrow[1] = HALO + ((size_t)(pm * 4 + 0) * 2) * DFF; hrow[2] = HALO + ((size_t)(pm * 4 + 1) * 2) * DFF; }
        else { zero2 = (t17 == 0 || t17 == 16); hrow[0] = HALO + ((size_t)(pm * 4 + 2) * 2) * DFF; hrow[1] = HALO + ((size_t)(pm * 4 + 3) * 2) * DFF; hrow[2] = HALO + ((size_t)((pm + 1) * 4 + 0) * 2) * DFF; }
        f32x4 cg = (f32x4){0.f, 0.f, 0.f, 0.f}, cu = cg;
#pragma unroll
        for (int j = 0; j < 3; ++j) {
            const bool z = (j == 0 && zero0) || (j == 2 && zero2);
            if (!z) { const f32x4 g = *(const GAS f32x4*)(hrow[j] + col), u = *(const GAS f32x4*)(hrow[j] + DFF + col);
                cg += g * *(const GAS f32x4*)(cw + (size_t)j * NUP + col); cu += u * *(const GAS f32x4*)(cw + (size_t)j * NUP + DFF + col); }
        }
        f32x4 o;
#pragma unroll
        for (int e = 0; e < 4; ++e) o[e] = cg[e] * __builtin_amdgcn_rcpf(1.f + __expf(-cg[e])) * cu[e];
        v2u w; w.x = pk2(o[0], o[1]); w.y = pk2(o[2], o[3]);
        *(v2u*)(ACT + (size_t)(pm * 256 + (edge ? 255 : 0)) * DFF + col) = w;
    }
}

__device__ __forceinline__ void ph_sc_fix(KAp ka, int i, bool latent, const int wv) {
    const TI t = thread_info(wv); const int gw = t.gw, NGW = t.NGW, lane = t.lane;
    const GAS float* HALO = (const GAS float*)(ka->ws + WS_SCHALO); const bf16* BB = (const bf16*)(ka->ws + WS_BB); bf16* O = (bf16*)(ka->ws + WS_O);
    const GAS float* cw = (const GAS float*)(A_SCCONV(ka) + (size_t)i * 3 * DM);
    const int ntile = latent ? 128 : NTM, nitems = ntile * 2 * 8;
    for (int it = gw; it < nitems; it += NGW) {
        const int ch = it & 7, edge = (it >> 3) & 1, tv = it >> 4, pm = latent ? tv + (tv >> 4) + 1 : tv, t17 = pm % 17;
        const int col = ch * 256 + lane * 4, row = pm * 256 + (edge ? 255 : 0);
        const GAS float* hrow[3]; bool zero0 = false, zero2 = false;
        if (edge == 0) { zero0 = (t17 == 0 || t17 == 1); hrow[0] = HALO + (size_t)((pm - 1) * 4 + 3) * DM; hrow[1] = HALO + (size_t)(pm * 4 + 0) * DM; hrow[2] = HALO + (size_t)(pm * 4 + 1) * DM; }
        else { zero2 = (t17 == 0 || t17 == 16); hrow[0] = HALO + (size_t)(pm * 4 + 2) * DM; hrow[1] = HALO + (size_t)(pm * 4 + 3) * DM; hrow[2] = HALO + (size_t)((pm + 1) * 4 + 0) * DM; }
        f32x4 cv = (f32x4){0.f, 0.f, 0.f, 0.f};
#pragma unroll
        for (int j = 0; j < 3; ++j) { const bool z = (j == 0 && zero0) || (j == 2 && zero2);
            if (!z) cv += *(const GAS f32x4*)(hrow[j] + col) * *(const GAS f32x4*)(cw + (size_t)j * DM + col); }
        const v2u bw = *(const v2u*)(BB + (size_t)row * DM + col);
        const f32x4 o = cv * (f32x4){bflo(bw.x), bfhi(bw.x), bflo(bw.y), bfhi(bw.y)};
        v2u w; w.x = pk2(o[0], o[1]); w.y = pk2(o[2], o[3]);
        *(v2u*)(O + (size_t)row * DM + col) = w;
    }
}
__device__ __forceinline__ void ph_sc_gate(const bf16* IN, bf16* OUT, const float* cw, int ntile, bool latent, const int wv) {
    const TI t = thread_info(wv); const int gw = t.gw, NGW = t.NGW, lane = t.lane;
    const int nitems = ntile * 4 * 8;
    for (int it = gw; it < nitems; it += NGW) {
        const int seg = it & 7, cc = (it >> 3) & 3, tv = it >> 5, pm = latent ? tv + (tv >> 4) + 1 : tv;
        const int col = cc * 512 + lane * 8, R0 = pm * 256 + seg * 32;
        f32x4 w0[3], w1[3];
#pragma unroll
        for (int j = 0; j < 3; ++j) { w0[j] = *(const f32x4*)(cw + (size_t)j * DM + col); w1[j] = *(const f32x4*)(cw + (size_t)j * DM + col + 4); }
        struct Row { f32x4 p0, p1; v4u g; };
        const v4u z4 = (v4u){0u, 0u, 0u, 0u};
#define SG_LOAD(R, D) do { const bf16* rp = IN + (size_t)(R) * NSC + col; D.g = *(const v4u*)rp; const v4u a = *(const v4u*)(rp + DM), b = *(const v4u*)(rp + 2 * DM); \
            D.p0 = (f32x4){bflo(a.x) * bflo(b.x), bfhi(a.x) * bfhi(b.x), bflo(a.y) * bflo(b.y), bfhi(a.y) * bfhi(b.y)}; \
            D.p1 = (f32x4){bflo(a.z) * bflo(b.z), bfhi(a.z) * bfhi(b.z), bflo(a.w) * bflo(b.w), bfhi(a.w) * bfhi(b.w)}; } while (0)
#define SG_ZERO(D) do { D.p0 = (f32x4){0.f, 0.f, 0.f, 0.f}; D.p1 = D.p0; D.g = z4; } while (0)
        Row rp_, rc_, rn1, rn2, rn3;
        const int tt0 = R0 % TPB; const bool top = (tt0 == 0 || tt0 == CTXL), bot = ((tt0 + 31) == CTXL - 1 || (tt0 + 31) == TPB - 1);
        if (top) SG_ZERO(rp_); else SG_LOAD(R0 - 1, rp_);
        SG_LOAD(R0, rc_); SG_LOAD(R0 + 1, rn1); SG_LOAD(R0 + 2, rn2);
        for (int i = 0; i < 32; ++i) {
            if (i + 3 < 32 || (i + 3 == 32 && !bot)) SG_LOAD(R0 + i + 3, rn3); else SG_ZERO(rn3);
            f32x4 o0 = rp_.p0 * w0[0] + rc_.p0 * w0[1] + rn1.p0 * w0[2], o1 = rp_.p1 * w1[0] + rc_.p1 * w1[1] + rn1.p1 * w1[2];
            const v4u g = rc_.g;
            o0 = o0 * (f32x4){bflo(g.x), bfhi(g.x), bflo(g.y), bfhi(g.y)}; o1 = o1 * (f32x4){bflo(g.z), bfhi(g.z), bflo(g.w), bfhi(g.w)};
            v4u ov; ov.x = pk2(o0[0], o0[1]); ov.y = pk2(o0[2], o0[3]); ov.z = pk2(o1[0], o1[1]); ov.w = pk2(o1[2], o1[3]);
            *(v4u*)(OUT + (size_t)(R0 + i) * DM + col) = ov;
            rp_ = rc_; rc_ = rn1; rn1 = rn2; rn2 = rn3;
        }
#undef SG_LOAD
#undef SG_ZERO
    }
}

__global__ void __launch_bounds__(NWAVES * 64, 2) __attribute__((amdgpu_flat_work_group_size(NWAVES * 64, NWAVES * 64))) dit_fwd(Args args_by_kernarg) {
    extern __shared__ __attribute__((aligned(16))) unsigned char lds[];
    LAS unsigned char* ldsl = (LAS unsigned char*)lds;
    (void)args_by_kernarg;
    for (int u = threadIdx.x; u < (LDS_BYTES - LDSCTL_OFF) / 4; u += NWAVES * 64) ((LAS unsigned*)(ldsl + LDSCTL_OFF))[u] = 0u;
    __syncthreads();
#if MK_ONE_LAUNCH
    XcdBarrier bar = xcd_barrier_post((unsigned*)(kargs()->ws + WS_CTL) + CW_BAR, (volatile LAS unsigned*)(ldsl + MISC_OFF) + 8);
#define GRID_BAR() do { XcdBarrier b2_ = bar; asm volatile("" : "+s"(b2_.bar)); int w0_ = wave0; asm volatile("" : "+s"(w0_)); xcd_barrier(b2_, w0_ == 0 && pg8::lane_id_l() == 0); } while (0)
#else
#define GRID_BAR() do { } while (0)
#endif
    const int wave0 = __builtin_amdgcn_readfirstlane((int)threadIdx.x >> 6);
    const int lo = kargs()->ph_lo, hi = kargs()->ph_hi;
    int ph = 0;
#define PH_BEGIN if (ph >= lo && ph < hi) { const KAp ka = kargs(); unsigned char* const ws = ka->ws; int L = l; asm volatile("" : "+s"(L)); int HF = half; asm volatile("" : "+s"(HF)); int WV = wave0; asm volatile("" : "+s"(WV)); (void)L; (void)HF; (void)ws;
#define PH_END } if (ph >= lo && ph + 1 < hi) { GRID_BAR(); } ++ph;
#define GEMM_RUN(EPI) pg8::gemm_phase<EPI, pg8::Order, true, true>(ldsl + RING_OFF, g, S, E, WV)

    { const int l = 0, half = 0;
      PH_BEGIN ph_prologue(ka, ldsl, WV); PH_END
      PH_BEGIN ph_modfin(ka, WV); PH_END
      PH_BEGIN {
          const TI t = thread_info(WV);
          pg8::Gemm g{(const bf16*)(ws + WS_SHIFT), (const bf16*)(ws + WS_W), 256, pg8::SB_LD, DM}; pg8::OrderSB S; S.init(0, t.bx, t.G);
          pg8::EpiSB E{(float*)(ws + WS_SB)};
          pg8::gemm_phase<pg8::EpiSB, pg8::OrderSB, true, true>(ldsl + RING_OFF, g, S, E, WV);
          ph_xinit(ka, WV, 2 * pg8::NSBT_UP + pg8::NSBT_IN + pg8::NSBT_SC < t.G ? 2 * pg8::NSBT_UP + pg8::NSBT_IN + pg8::NSBT_SC : t.G); } PH_END }

    for (int l = 0; l < 4; ++l) {
        const int half = 0;
        if (!(l & 1)) {
            PH_BEGIN {
                const TI t = thread_info(WV); const int i = L >> 1;
                pg8::Gemm g{(const bf16*)(ws + WS_H), (const bf16*)(ws + WS_W_IN + i * W_IN_SZ), MR, NPROJP, DM}; pg8::Order S; S.init(NTM, NPROJP / 256, t.G, t.bx, 0, 0);
                pg8::EpiStoreBf16N<NPROJP> E{(bf16*)(ws + WS_PROJ), (const float*)(ws + WS_SS), (const float*)(ws + WS_SB) + (size_t)((L * 2 + 0) * 9) * pg8::SB_LD + SB_COL_IN + i * NPROJP, (LAS float*)(ldsl + XTRA_OFF + 9216)};
                GEMM_RUN(pg8::EpiStoreBf16N<NPROJP>);
                if (L == 0) { const TI t2 = thread_info(WV); const int nheavy = (NTM * (NPROJP / 256)) % t2.G; if (t2.bx >= nheavy) ph_att0_tr(ka, ldsl, WV, t2.bx - nheavy, t2.G - nheavy); } } PH_END
            PH_BEGIN ph_attn_post(ka, L >> 1, WV); PH_END
            PH_BEGIN {
                const TI t = thread_info(WV); const int i = L >> 1;
                { pg8::Gemm g{(const bf16*)(ws + WS_CQ), (const bf16*)(ws + WS_W_UQ + i * W_UQ_SZ), MR, NQB, 512}; pg8::Order S; S.init(L == 0 ? NTM : 128, NQB / 256, t.G, t.bx, L == 0 ? 0 : 1, 0);
                  pg8::EpiStoreBf16<NQB> E{(bf16*)(ws + WS_QB)};
                  GEMM_RUN(pg8::EpiStoreBf16<NQB>); }
                { pg8::Gemm g{(const bf16*)(ws + WS_CKV), (const bf16*)(ws + WS_W_UKV + i * W_UKV_SZ), MR, NKVB, 256}; const int rot = ((((L == 0 ? NTM : 128) * (NQB / 256)) % t.G) / 8) * 8;
                  pg8::Order S; S.init(NTM, NKVB / 256, t.G, (t.bx + t.G - rot) % t.G, 0, 0);
                  pg8::EpiStoreBf16<NKVB> E{(bf16*)(ws + WS_KVB)};
                  GEMM_RUN(pg8::EpiStoreBf16<NKVB>); } } PH_END
            PH_BEGIN { {
                const TI t = thread_info(WV);
                const bf16* QA = (const bf16*)(ws + WS_QA); const bf16* KA = (const bf16*)(ws + WS_KA); const bf16* PROJ = (const bf16*)(ws + WS_PROJ); bf16* OB = (bf16*)(ws + WS_O);
                const int nA = (L == 0) ? 1280 : 1024;
                for (int a = t.vcu; a < nA; a += t.G) {
                    int b, h, qrow0, seq;
                    if (a < 1024) { const int ii = a >> 8, xx = (a >> 5) & 7, j = a & 31; b = xx; h = 2 * ii + (j >> 4); qrow0 = b * TPB + CTXL + (j & 15) * 256; seq = TPB; }
                    else { const int xx = (a - 1024) >> 5, j = (a - 1024) & 31; if (j >= 8) continue; b = xx; h = j; qrow0 = b * TPB; seq = CTXL; }
                    const size_t kv0 = (size_t)b * TPB;
                    att::attn_unit<128, 2, NPROJP, 256, NPROJP, DM>(PROJ + (size_t)qrow0 * NPROJP + h * 128, KA + kv0 * 256 + (h >> 2) * 128, nullptr,
                                           PROJ + kv0 * NPROJP + 1280 + (h >> 2) * 128, OB + (size_t)qrow0 * DM + h * 128, seq, 0.08838834764831845f, (char*)lds, WV, (const float*)(ws + WS_TAB), a < 1024 ? (a & 15) * 256 : -1,
                                           A_QNORM(ka) + (L >> 1) * 128);
                } }
              {
                const TI t = thread_info(WV);
                const bf16* QB = (const bf16*)(ws + WS_QB); const bf16* KVB = (const bf16*)(ws + WS_KVB); const bf16* KR = (const bf16*)(ws + WS_KR); bf16* OB = (bf16*)(ws + WS_O);
                const int nA = (L == 0) ? 1280 : 1024;
                for (int a = t.vcu; a < nA; a += t.G) {
                    int b, h, qrow0, seq;
                    const int j_ = a & 31;
                    if (a < 1024) { const int ii = a >> 8, xx = (a >> 5) & 7, j = a & 31; b = xx; h = 2 * ii + (j >> 4); qrow0 = b * TPB + CTXL + (j & 15) * 256; seq = TPB; }
                    else { const int xx = (a - 1024) >> 5, j = (a - 1024) & 31; if (j < 8 || j >= 16) continue; b = xx; h = j - 8; qrow0 = b * TPB; seq = CTXL; }
                    const size_t kv0 = (size_t)b * TPB;
                    att::attn_unit<192, 1, NQB, NKVB, NKVB, DM>(QB + (size_t)qrow0 * NQB + h * 192, KVB + kv0 * NKVB + h * 256, KR + kv0 * 64,
                                           KVB + kv0 * NKVB + h * 256 + 128, OB + (size_t)qrow0 * DM + 1024 + h * 128, seq, 0.07216878364870323f, (char*)lds, WV, (const float*)(ws + WS_TAB + 16384), a < 1024 ? (j_ & 15) * 256 : -1, nullptr);
                } } } PH_END
            PH_BEGIN {
                const TI t = thread_info(WV); const int i = L >> 1;
                pg8::Gemm g{(const bf16*)(ws + WS_O), (const bf16*)(ws + WS_W_O + i * W_O_SZ), MR, DM, DM}; pg8::OrderSplit S; S.init(DM / 256, t.G, t.bx, DM / 64, L == 0 ? 8 : 0);
                pg8::EpiResidNorm E{(bf16*)(ws + WS_X), (const float*)(ws + WS_MOD) + (size_t)L * 9 * MODW + 2 * DM, (bf16*)(ws + WS_H), (const float*)(ws + WS_WEFF) + (size_t)((L * 2 + 1) * 9) * DM,
                                    (float*)(ws + WS_SS), (LAS float*)(ldsl + XTRA_OFF), 1, (float*)(ws + WS_SLAB), DM / 64, (LAS float*)(ldsl + XTRA_OFF + 9216)};
                pg8::gemm_phase<pg8::EpiResidNorm, pg8::OrderSplit, true, true>(ldsl + RING_OFF, g, S, E, WV); } PH_END
            if (l == 0) { PH_BEGIN ph_ctx_combine(ka, (const float*)(ws + WS_MOD) + ((size_t)L * 9 + 8) * MODW + 2 * DM, (const float*)(ws + WS_WEFF) + (size_t)((L * 2 + 1) * 9 + 8) * DM, true, WV); PH_END }
        } else {
            PH_BEGIN {
                const TI t = thread_info(WV); const int i = L >> 1; const bool ctxl = L < 2;
                pg8::Gemm g{(const bf16*)(ws + WS_H), (const bf16*)(ws + WS_W_SCIN + i * W_SCIN_SZ), MR, NSC, DM}; pg8::OrderSc S; S.init(ctxl ? NTM : 128, t.G, t.bx, ctxl ? 0 : 1);
                pg8::EpiScIn E{(bf16*)(ws + WS_BB), (bf16*)(ws + WS_O), (float*)(ws + WS_SCHALO), A_SCCONV(ka) + (size_t)i * 3 * DM, (LAS float*)(ldsl + XTRA_OFF),
                               (const float*)(ws + WS_SS), (const float*)(ws + WS_SB) + (size_t)((L * 2 + 0) * 9) * pg8::SB_LD + SB_COL_SCIN + i * NSC, (LAS float*)(ldsl + XTRA_OFF + 9216)};
                pg8::gemm_phase<pg8::EpiScIn, pg8::OrderSc, true, true>(ldsl + RING_OFF, g, S, E, WV);
                if (L == 1) { const TI t2 = thread_info(WV); const int nheavy = (NTM * 8) % t2.G; if (t2.bx >= nheavy) { ph_late_tr(ka, ldsl, WV, t2.bx - nheavy, t2.G - nheavy);
                        __syncthreads();
                        pg8::Gemm g2{(const bf16*)(ka->ws + WS_SHIFT), (const bf16*)(ka->ws + WS_W), 256, pg8::SB_LD, DM}; pg8::OrderSB S2; S2.init(1, t2.bx - nheavy, t2.G - nheavy);
                        pg8::EpiSB E2{(float*)(ka->ws + WS_SB)}; pg8::gemm_phase<pg8::EpiSB, pg8::OrderSB, true, true>(ldsl + RING_OFF, g2, S2, E2, WV); } } } PH_END
            PH_BEGIN ph_sc_fix(ka, L >> 1, L >= 2, WV); PH_END
            PH_BEGIN {
                const TI t = thread_info(WV); const int i = L >> 1;
                pg8::Gemm g{(const bf16*)(ws + WS_O), (const bf16*)(ws + WS_W_SCOUT + i * W_SCOUT_SZ), MR, DM, DM}; pg8::OrderSplit S; S.init(DM / 256, t.G, t.bx, DM / 64, L < 2 ? 8 : 0);
                pg8::EpiResidNorm E{(bf16*)(ws + WS_X), (const float*)(ws + WS_MOD) + (size_t)L * 9 * MODW + 2 * DM, (bf16*)(ws + WS_H), (const float*)(ws + WS_WEFF) + (size_t)((L * 2 + 1) * 9) * DM,
                                    (float*)(ws + WS_SS), (LAS float*)(ldsl + XTRA_OFF), 1, (float*)(ws + WS_SLAB), DM / 64, (LAS float*)(ldsl + XTRA_OFF + 9216)};
                pg8::gemm_phase<pg8::EpiResidNorm, pg8::OrderSplit, true, true>(ldsl + RING_OFF, g, S, E, WV); } PH_END
            if (l == 1) { PH_BEGIN ph_ctx_combine(ka, (const float*)(ws + WS_MOD) + ((size_t)L * 9 + 8) * MODW + 2 * DM, (const float*)(ws + WS_WEFF) + (size_t)((L * 2 + 1) * 9 + 8) * DM, true, WV); PH_END }
        }
        PH_BEGIN {
                const TI t = thread_info(WV); const bool ctxl = L < 2;
                pg8::Gemm g{(const bf16*)(ws + WS_H), (const bf16*)(ws + WS_W_UP + L * W_UP_SZ), MR, NUP, DM}; pg8::Order S; S.init(ctxl ? NTM : 128, NUP / 256, t.G, t.bx, ctxl ? 0 : 1, 0);
                pg8::EpiConvGate E{(bf16*)(ws + WS_ACT), (float*)(ws + WS_HALO), A_FCONV(ka) + (size_t)L * 3 * NUP, (LAS float*)(ldsl + XTRA_OFF),
                                   (const float*)(ws + WS_SS), (const float*)(ws + WS_SB) + (size_t)((L * 2 + 1) * 9) * pg8::SB_LD + SB_COL_UP + L * NUP, (LAS float*)(ldsl + XTRA_OFF + 9216)};
                GEMM_RUN(pg8::EpiConvGate);
                if (L == 0) { const TI t2 = thread_info(WV); const int nheavy = (NTM * (NUP / 256)) % t2.G; if (t2.bx >= nheavy) ph_dn0_tr(ka, ldsl, WV, t2.bx - nheavy, t2.G - nheavy); } } PH_END
        PH_BEGIN ph_ffn_fix(ka, L, L >= 2, WV); PH_END
        PH_BEGIN {
                const TI t = thread_info(WV); const int ln = L < 3 ? L + 1 : 3;
                pg8::Gemm g{(const bf16*)(ws + WS_ACT), (const bf16*)(ws + WS_W_DN + L * W_DN_SZ), MR, DM, DFF}; pg8::OrderSplit S; S.init(DM / 256, t.G, t.bx, DFF / 64, L < 2 ? 8 : 0);
                pg8::EpiResidNorm E{(bf16*)(ws + WS_X), (const float*)(ws + WS_MOD) + (size_t)L * 9 * MODW + 5 * DM, (bf16*)(ws + WS_H), (const float*)(ws + WS_WEFF) + (size_t)((ln * 2 + 0) * 9) * DM,
                                    (float*)(ws + WS_SS), (LAS float*)(ldsl + XTRA_OFF), L < 3 ? 1 : 0, (float*)(ws + WS_SLAB), DFF / 64, (LAS float*)(ldsl + XTRA_OFF + 9216)};
                pg8::gemm_phase<pg8::EpiResidNorm, pg8::OrderSplit, true, true>(ldsl + RING_OFF, g, S, E, WV); } PH_END
        if (l < 2) { PH_BEGIN ph_ctx_combine(ka, (const float*)(ws + WS_MOD) + ((size_t)L * 9 + 8) * MODW + 5 * DM, (const float*)(ws + WS_WEFF) + (size_t)(((L + 1) * 2 + 0) * 9 + 8) * DM, true, WV); PH_END }
    }
    { const int l = 0, half = 0;
      PH_BEGIN ph_final(ka, WV); PH_END }
#undef PH_BEGIN
#undef PH_END
#undef GEMM_RUN
}

extern "C" void kernel_launch(void* const* d_in, const int* in_sizes, int n_in, void* d_out, int out_size, void* d_ws, size_t ws_size, hipStream_t stream) {
    static int grid = 0;
    if (grid == 0) {
        if (n_in != 23 || in_sizes[0] != NB * SEQ * DM || out_size != NB * SEQ * DM || ws_size < WS_END) {
            fprintf(stderr, "kernel_launch: built for 23 inputs, x/out of %d floats, >= %zu bytes of workspace; got n_in %d, in0 %d, out %d, ws %zu; nothing launched\n",
                    NB * SEQ * DM, (size_t)WS_END, n_in, n_in > 0 ? in_sizes[0] : -1, out_size, ws_size); grid = -1; return; }
        int dev = 0, cus = 0, per_cu = 0;
        if (hipGetDevice(&dev) != hipSuccess || hipDeviceGetAttribute(&cus, hipDeviceAttributeMultiprocessorCount, dev) != hipSuccess) { fprintf(stderr, "kernel_launch: device query failed\n"); grid = -1; return; }
        if (hipFuncSetAttribute((const void*)dit_fwd, hipFuncAttributeMaxDynamicSharedMemorySize, LDS_BYTES) != hipSuccess) { fprintf(stderr, "kernel_launch: hipFuncSetAttribute(%d B LDS) failed\n", LDS_BYTES); grid = -1; return; }
        if (hipOccupancyMaxActiveBlocksPerMultiprocessor(&per_cu, (const void*)dit_fwd, NWAVES * 64, LDS_BYTES) != hipSuccess || per_cu < 1)
            fprintf(stderr, "kernel_launch: note: occupancy query reports %d workgroups per CU\n", per_cu);
        (void)hipGetLastError();
        grid = cus;
    }
    if (grid < 0) return;
    if (hipMemsetAsync((char*)d_ws + WS_CTL, 0, CTL_ZERO_BYTES, stream) != hipSuccess) { fprintf(stderr, "kernel_launch: hipMemsetAsync failed\n"); return; }
    Args a{};
    for (int i = 0; i < 23; ++i) a.in[i] = (const float*)d_in[i];
    a.out = (float*)d_out; a.ws = (unsigned char*)d_ws;
#if MK_ONE_LAUNCH
    a.ph_lo = 0; a.ph_hi = NPH;
    hipLaunchKernelGGL(dit_fwd, dim3(grid), dim3(NWAVES * 64), LDS_BYTES, stream, a);
#else
    for (int p = 0; p < NPH; ++p) { a.ph_lo = p; a.ph_hi = p + 1; hipLaunchKernelGGL(dit_fwd, dim3(grid), dim3(NWAVES * 64), LDS_BYTES, stream, a); }
#endif
    const hipError_t le = hipPeekAtLastError();
    if (le != hipSuccess) fprintf(stderr, "kernel_launch: launch failed: %s (grid %d)\n", hipGetErrorName(le), grid);
}
```

```cpp
#include <hip/hip_runtime.h>
#include <hip/hip_bf16.h>
#include <cstdio>
#include <cstdint>
namespace pg8 {
#define PG8_LAS __attribute__((address_space(3)))
typedef unsigned short bf16_t;
typedef short bf16x8 __attribute__((ext_vector_type(8)));
typedef float f32x4 __attribute__((ext_vector_type(4)));
typedef unsigned u32x4 __attribute__((ext_vector_type(4)));
typedef unsigned u32x2 __attribute__((ext_vector_type(2)));
constexpr int NSBT_IN = 10, NSBT_SC = 24, NSBT_UP = 44;
constexpr int BM = 256, BK = 64, HALF = 128, HTB = HALF * BK * 2  , STAGE_BYTES = 8 * HTB, NXCD = 8, WGM = 8;

__host__ __device__ __forceinline__ int lds_byte(int r, int c) { const int st = (r >> 4) * 2 + (c >> 5), rr = r & 15, cc = c & 31, ob = rr * 64 + cc * 2; return st * 1024 + (ob ^ (((ob >> 9) & 1) << 5)); }
__host__ __device__ __forceinline__ void stage_rc(int b, int& R, int& C) { const int st = b / 1024, sb = b % 1024, swz = sb ^ (((sb >> 9) & 1) << 5); R = (st >> 1) * 16 + swz / 64; C = (st & 1) * 32 + (swz % 64) / 2; }
__host__ __device__ __forceinline__ int perm32(int rho) { const int n = rho >> 4, i = rho & 15; return 8 * (i >> 2) + 4 * n + (i & 3); }

__device__ __forceinline__ int lane_id_l() { int l = (int)__builtin_amdgcn_mbcnt_hi(~0u, __builtin_amdgcn_mbcnt_lo(~0u, 0u)); asm volatile("" : "+v"(l)); return l; }
struct Unit { int pm, pn, kb, nt; };
struct Gemm { const bf16_t* A; const bf16_t* Bt; int M, N, K; };

struct StaticOrder {
    static constexpr bool SPLIT = false;
    int nM, nN, nwg, G, c;
    __host__ __device__ void init(int M, int N, int G_, int c_) { nM = M / BM; nN = N / BM; nwg = nM * nN; G = G_; c = c_; }
    __host__ __device__ bool next(int i, Unit& u) const {
        const long L = (long)i * G + c; if (L >= nwg) return false;
        int wgid = (int)L; { const int q = nwg / NXCD, r = nwg % NXCD, xcd = wgid % NXCD, off = wgid / NXCD; wgid = (xcd < r ? xcd * (q + 1) : r * (q + 1) + (xcd - r) * q) + off; }
        const int nig = WGM * nN, gid = wgid / nig, fm = gid * WGM, gsz = (nM - fm) < WGM ? (nM - fm) : WGM;
        u.pm = fm + ((wgid % nig) % gsz); u.pn = (wgid % nig) / gsz; u.kb = 0; u.nt = 0; return true;
    }
    __device__ __forceinline__ void a_ready(const Unit&) const {}
    __device__ __forceinline__ void done(const Unit&) const {}
};

__device__ __forceinline__ unsigned cvt_pk_bf16(float lo, float hi) { unsigned r; asm volatile("v_cvt_pk_bf16_f32 %0, %1, %2" : "=v"(r) : "v"(lo), "v"(hi)); return r; }
typedef float f32x2 __attribute__((ext_vector_type(2)));

constexpr int SB_LD = 62464;
template <int LDC> struct EpiStoreBf16 {
    static constexpr bool PREF = false, PERM = true, AFTER_DRAIN = false, APERM = false; static constexpr int ldc = LDC;
    bf16_t* O;
    __device__ __forceinline__ void operator()(const f32x4 (&acc)[2][2][4][2], const Unit& u, int wr, int wc, int fr, int fq) const {
        { const int t_ = lane_id_l(); fr = t_ & 15; fq = t_ >> 4; }
        const int row0 = u.pm * BM + wr * 64 + fr, col0 = u.pn * BM + wc * 32 + 8 * fq;
#pragma unroll
        for (int ai = 0; ai < 2; ++ai)
#pragma unroll
            for (int m = 0; m < 4; ++m) { bf16_t* rowp = O + (size_t)(row0 + ai * HALF + m * 16) * ldc + col0;
#pragma unroll
                for (int bj = 0; bj < 2; ++bj) { const f32x4 v0 = acc[ai][bj][m][0], v1 = acc[ai][bj][m][1];
                    u32x4 w; w.x = cvt_pk_bf16(v0[0], v0[1]); w.y = cvt_pk_bf16(v0[2], v0[3]); w.z = cvt_pk_bf16(v1[0], v1[1]); w.w = cvt_pk_bf16(v1[2], v1[3]);
                    *(u32x4*)(rowp + bj * HALF) = w; } }
    }
};

template <bool APERM_>
__device__ __forceinline__ void apply_rstd_sb(f32x4 (&acc)[2][2][4][2], const Unit& u, int wr, int wc, int fr, int fq, const float* SS, const float* sb  , int sbld) {
    float rs[2][4]; f32x4 sv[2][2];
    const int tb = (u.pm % 17 == 0) ? 8 : u.pm / 17;
    const float* sp = sb + (size_t)tb * sbld + u.pn * BM + wc * 32 + 8 * fq;
    {
        f32x4 a[2][4], b[2][4];
#pragma unroll
        for (int ai = 0; ai < 2; ++ai)
#pragma unroll
            for (int m = 0; m < 4; ++m) { const float* q = SS + (size_t)(u.pm * BM + ai * HALF + wr * 64 + (APERM_ ? 4 * fr + m : m * 16 + fr)) * 8; a[ai][m] = *(const f32x4*)q; b[ai][m] = *(const f32x4*)(q + 4); }
#pragma unroll
        for (int bj = 0; bj < 2; ++bj)
#pragma unroll
            for (int n = 0; n < 2; ++n) sv[bj][n] = *(const f32x4*)(sp + bj * HALF + 4 * n);
#pragma unroll
        for (int ai = 0; ai < 2; ++ai)
#pragma unroll
            for (int m = 0; m < 4; ++m) rs[ai][m] = __builtin_amdgcn_rsqf((((a[ai][m][0] + a[ai][m][1]) + (a[ai][m][2] + a[ai][m][3])) + ((b[ai][m][0] + b[ai][m][1]) + (b[ai][m][2] + b[ai][m][3]))) * (1.f / 2048.f) + 1e-6f);
        asm volatile("" : "+v"(rs[0][0]), "+v"(rs[0][1]), "+v"(rs[0][2]), "+v"(rs[0][3]), "+v"(rs[1][0]), "+v"(rs[1][1]), "+v"(rs[1][2]), "+v"(rs[1][3]) :: "memory");
    }
#pragma unroll
    for (int bj = 0; bj < 2; ++bj)
#pragma unroll
        for (int n = 0; n < 2; ++n)
#pragma unroll
            for (int ai = 0; ai < 2; ++ai)
#pragma unroll
                for (int m = 0; m < 4; ++m) acc[ai][bj][m][n] = acc[ai][bj][m][n] * rs[ai][m] + sv[bj][n];
}
__device__ __forceinline__ void ss_pref_issue(const Unit& u, int wid, int lane, const float* SS, const float* sb, int sbld, PG8_LAS float* ssl) {
    __builtin_amdgcn_global_load_lds((const unsigned*)(SS + (size_t)(u.pm * BM) * 8 + (wid * 64 + lane) * 4), (PG8_LAS unsigned*)(ssl + wid * 256), 16, 0, 0);
    if (wid == 0) { const int tb = (u.pm % 17 == 0) ? 8 : u.pm / 17;
        __builtin_amdgcn_global_load_lds((const unsigned*)(sb + (size_t)tb * sbld + u.pn * BM + lane * 4), (PG8_LAS unsigned*)(ssl + 2304), 16, 0, 0); }
}
__device__ __forceinline__ void ss_pref_reduce(int tid, PG8_LAS float* ssl) {
    if (tid < 256) { const f32x4 a = *(const PG8_LAS f32x4*)(ssl + tid * 8), b = *(const PG8_LAS f32x4*)(ssl + tid * 8 + 4);
        ssl[2048 + tid] = __builtin_amdgcn_rsqf((((a[0] + a[1]) + (a[2] + a[3])) + ((b[0] + b[1]) + (b[2] + b[3]))) * (1.f / 2048.f) + 1e-6f); }
}
template <bool APERM_>
__device__ __forceinline__ void apply_rstd_sb_l(f32x4 (&acc)[2][2][4][2], int wr, int wc, int fr, int fq, const PG8_LAS float* ssl) {
    float rs[2][4]; f32x4 sv[2][2];
#pragma unroll
    for (int ai = 0; ai < 2; ++ai) {
        if constexpr (APERM_) { const f32x4 r = *(const PG8_LAS f32x4*)(ssl + 2048 + ai * HALF + wr * 64 + 4 * fr); rs[ai][0] = r[0]; rs[ai][1] = r[1]; rs[ai][2] = r[2]; rs[ai][3] = r[3]; }
        else {
#pragma unroll
            for (int m = 0; m < 4; ++m) rs[ai][m] = ssl[2048 + ai * HALF + wr * 64 + m * 16 + fr]; } }
#pragma unroll
    for (int bj = 0; bj < 2; ++bj)
#pragma unroll
        for (int n = 0; n < 2; ++n) sv[bj][n] = *(const PG8_LAS f32x4*)(ssl + 2304 + bj * HALF + wc * 32 + 8 * fq + 4 * n);
#pragma unroll
    for (int bj = 0; bj < 2; ++bj)
#pragma unroll
        for (int n = 0; n < 2; ++n)
#pragma unroll
            for (int ai = 0; ai < 2; ++ai)
#pragma unroll
                for (int m = 0; m < 4; ++m) acc[ai][bj][m][n] = acc[ai][bj][m][n] * rs[ai][m] + sv[bj][n];
}
template <int LDC> struct EpiStoreBf16N {
    static constexpr bool PREF = true, PERM = true, AFTER_DRAIN = false, APERM = false; static constexpr int ldc = LDC, sbld = SB_LD;
    bf16_t* O; const float* SS; const float* sb; PG8_LAS float* ssl;
    __device__ __forceinline__ void pref_issue(const Unit& u, int wid) const { const int lane = lane_id_l();     ss_pref_issue(u, wid, lane, SS, sb, sbld, ssl); }
    __device__ __forceinline__ void pref_reduce(int wid) const { const int tid = wid * 64 + lane_id_l(); ss_pref_reduce(tid, ssl); }
    __device__ __forceinline__ void operator()(f32x4 (&acc)[2][2][4][2], const Unit& u, int wr, int wc, int fr, int fq) const {
        { const int t_ = lane_id_l(); fr = t_ & 15; fq = t_ >> 4; }
        apply_rstd_sb_l<false>(acc, wr, wc, fr, fq, ssl);
        const int row0 = u.pm * BM + wr * 64 + fr, col0 = u.pn * BM + wc * 32 + 8 * fq;
#pragma unroll
        for (int ai = 0; ai < 2; ++ai)
#pragma unroll
            for (int m = 0; m < 4; ++m) { bf16_t* rowp = O + (size_t)(row0 + ai * HALF + m * 16) * ldc + col0;
#pragma unroll
                for (int bj = 0; bj < 2; ++bj) { const f32x4 v0 = acc[ai][bj][m][0], v1 = acc[ai][bj][m][1];
                    u32x4 w; w.x = cvt_pk_bf16(v0[0], v0[1]); w.y = cvt_pk_bf16(v0[2], v0[3]); w.z = cvt_pk_bf16(v1[0], v1[1]); w.w = cvt_pk_bf16(v1[2], v1[3]);
                    *(u32x4*)(rowp + bj * HALF) = w; } }
    }
};
struct EpiSB {
    static constexpr bool PREF = false, PERM = false, AFTER_DRAIN = false, APERM = false; static constexpr int ldc = SB_LD;
    float* O;
    __device__ __forceinline__ void operator()(const f32x4 (&acc)[2][2][4][2], const Unit& u, int wr, int wc, int fr, int fq) const {
        const int col0 = u.pn * BM + wc * 32 + 4 * fq;
#pragma unroll
        for (int m = 0; m < 4; ++m) { const int row = wr * 64 + m * 16 + fr;
            if (row < 72) {
#pragma unroll
                for (int bj = 0; bj < 2; ++bj)
#pragma unroll
                    for (int n = 0; n < 2; ++n) *(f32x4*)(O + (size_t)row * ldc + col0 + bj * HALF + n * 16) = acc[0][bj][m][n]; } }
    }
};
struct EpiResidNorm {
    static constexpr bool PREF = true, PERM = true, AFTER_DRAIN = false, APERM = false;
    __device__ __forceinline__ void pref_issue(const Unit& u, int wid) const { const int lane = lane_id_l();
        if (u.nt == ntf && wid < 2) { const int tb = (u.pm % 17 == 0) ? 8 : u.pm / 17;
            if (wid == 0) __builtin_amdgcn_global_load_lds((const unsigned*)(gate + (size_t)tb * 12288 + u.pn * BM + lane * 4), (PG8_LAS unsigned*)gwl, 16, 0, 0);
            else if (donorm) __builtin_amdgcn_global_load_lds((const unsigned*)(weff + (size_t)tb * 2048 + u.pn * BM + lane * 4), (PG8_LAS unsigned*)(gwl + 256), 16, 0, 0); } }
    __device__ __forceinline__ void pref_reduce(int) const {}
    bf16_t* X; const float* gate; bf16_t* H; const float* weff; float* SS; PG8_LAS float* red; int donorm; float* slab; int ntf; PG8_LAS float* gwl;
    __device__ __forceinline__ void operator()(const f32x4 (&acc)[2][2][4][2], const Unit& u, int wr, int wc, int fr, int fq) const {
        { const int t_ = lane_id_l(); fr = t_ & 15; fq = t_ >> 4; }
        constexpr int LD = 2048;
        if (u.nt != ntf) {
            float* sp = slab + ((size_t)(u.kb / u.nt) * 2048 + (size_t)(u.pm / 17) * BM) * LD + u.pn * BM + wc * 32 + 8 * fq;
#pragma unroll
            for (int ai = 0; ai < 2; ++ai)
#pragma unroll
                for (int m = 0; m < 4; ++m) { float* rp = sp + (size_t)(ai * HALF + wr * 64 + m * 16 + fr) * LD;
#pragma unroll
                    for (int bj = 0; bj < 2; ++bj) { *(f32x4*)(rp + bj * HALF) = acc[ai][bj][m][0]; *(f32x4*)(rp + bj * HALF + 4) = acc[ai][bj][m][1]; } }
            return;
        }
        const int col0 = u.pn * BM + wc * 32 + 8 * fq;
        u32x4 xrA[2][4][2];
#pragma unroll
        for (int ai = 0; ai < 2; ++ai)
#pragma unroll
            for (int m = 0; m < 4; ++m)
#pragma unroll
                for (int bj = 0; bj < 2; ++bj) xrA[ai][m][bj] = *(const u32x4*)((const char*)X + (unsigned)(((u.pm * BM + ai * HALF + wr * 64 + m * 16 + fr) * LD + col0) * 2 + bj * (HALF * 2)));
#pragma unroll
        for (int ai = 0; ai < 2; ++ai) {
            float ss[4] = {0.f, 0.f, 0.f, 0.f};
#pragma unroll
            for (int bj = 0; bj < 2; ++bj) {
                f32x4 gv[2], wv[2];
#pragma unroll
                for (int n = 0; n < 2; ++n) { gv[n] = *(const PG8_LAS f32x4*)(gwl + bj * HALF + wc * 32 + 8 * fq + 4 * n); wv[n] = donorm ? *(const PG8_LAS f32x4*)(gwl + 256 + bj * HALF + wc * 32 + 8 * fq + 4 * n) : (f32x4){0.f, 0.f, 0.f, 0.f}; }
#pragma unroll
                for (int m = 0; m < 4; ++m) { const int trow = ai * HALF + wr * 64 + m * 16 + fr; const unsigned offb = (unsigned)(((u.pm * BM + trow) * LD + col0) * 2 + bj * (HALF * 2));
                    const u32x4 xv = xrA[ai][m][bj];
                    f32x4 x0, x1;
                    x0[0] = __uint_as_float(xv.x << 16); x0[1] = __uint_as_float(xv.x & 0xffff0000u); x0[2] = __uint_as_float(xv.y << 16); x0[3] = __uint_as_float(xv.y & 0xffff0000u);
                    x1[0] = __uint_as_float(xv.z << 16); x1[1] = __uint_as_float(xv.z & 0xffff0000u); x1[2] = __uint_as_float(xv.w << 16); x1[3] = __uint_as_float(xv.w & 0xffff0000u);
                    x0 = x0 + gv[0] * acc[ai][bj][m][0]; x1 = x1 + gv[1] * acc[ai][bj][m][1];
                    u32x4 xw; xw.x = cvt_pk_bf16(x0[0], x0[1]); xw.y = cvt_pk_bf16(x0[2], x0[3]); xw.z = cvt_pk_bf16(x1[0], x1[1]); xw.w = cvt_pk_bf16(x1[2], x1[3]); *(u32x4*)((char*)X + offb) = xw;
                    if (donorm) { ss[m] += (x0[0] * x0[0] + x0[1] * x0[1]) + (x0[2] * x0[2] + x0[3] * x0[3]) + (x1[0] * x1[0] + x1[1] * x1[1]) + (x1[2] * x1[2] + x1[3] * x1[3]);
                        const f32x4 a0 = x0 * wv[0], a1 = x1 * wv[1];
                        u32x4 w; w.x = cvt_pk_bf16(a0[0], a0[1]); w.y = cvt_pk_bf16(a0[2], a0[3]); w.z = cvt_pk_bf16(a1[0], a1[1]); w.w = cvt_pk_bf16(a1[2], a1[3]);
                        *(u32x4*)((char*)H + offb) = w; } }
                asm volatile("" ::: "memory");
            }
            if (donorm) {
#pragma unroll
                for (int m = 0; m < 4; ++m) { float s_ = ss[m]; s_ += __shfl_xor(s_, 16); s_ += __shfl_xor(s_, 32); if (fq == 0) red[(ai * HALF + wr * 64 + m * 16 + fr) * 4 + wc] = s_; } }
        }
        if (donorm) {
            asm volatile("s_waitcnt lgkmcnt(0)" ::: "memory"); __builtin_amdgcn_s_barrier(); asm volatile("" ::: "memory");
            const int t = (wr * 4 + wc) * 64 + fq * 16 + fr;
            if (t < 256) { const f32x4 r = *(const PG8_LAS f32x4*)(red + t * 4); SS[(size_t)(u.pm * BM + t) * 8 + u.pn] = (r[0] + r[1]) + (r[2] + r[3]); }
        }
    }
};

__device__ __forceinline__ float dpp_ror1(float v) { return __builtin_bit_cast(float, __builtin_amdgcn_update_dpp(0, __builtin_bit_cast(int, v), 0x121, 0xf, 0xf, false)); }
__device__ __forceinline__ float dpp_shr1_old(float old, float v) { return __builtin_bit_cast(float, __builtin_amdgcn_update_dpp(__builtin_bit_cast(int, old), __builtin_bit_cast(int, v), 0x111, 0xf, 0xf, false)); }
__device__ __forceinline__ float dpp_shl1_old(float old, float v) { return __builtin_bit_cast(float, __builtin_amdgcn_update_dpp(__builtin_bit_cast(int, old), __builtin_bit_cast(int, v), 0x101, 0xf, 0xf, false)); }
__device__ __forceinline__ float dpp_rol1(float v) { return __builtin_bit_cast(float, __builtin_amdgcn_update_dpp(0, __builtin_bit_cast(int, v), 0x12f, 0xf, 0xf, false)); }
struct EpiConvGate {
    static constexpr bool PREF = true , PERM = true, AFTER_DRAIN = false, APERM = true;
    bf16_t* ACT; float* HALO; const float* cw; PG8_LAS float* edge; const float* SS; const float* sb; PG8_LAS float* ssl;
    __device__ __forceinline__ void pref_issue(const Unit& u, int wid) const { const int lane = lane_id_l();     ss_pref_issue(u, wid, lane, SS, sb, SB_LD, ssl);
        if (wid >= 1 && wid <= 3) { const int r6 = 2 * (wid - 1) + (lane >> 5);
            __builtin_amdgcn_global_load_lds((const unsigned*)(cw + (size_t)(r6 >> 1) * (2 * 5632) + (r6 & 1) * 5632 + u.pn * 128 + (lane & 31) * 4), (PG8_LAS unsigned*)(ssl + 2560 + (wid - 1) * 256), 16, 0, 0); } }
    __device__ __forceinline__ void pref_reduce(int wid) const { const int tid = wid * 64 + lane_id_l(); ss_pref_reduce(tid, ssl);
        for (int idx = tid; idx < 768; idx += 512) ssl[2560 + idx] *= ((idx >> 7) & 1) ? -0.6931471805599453f : -1.4426950408889634f; }
    __device__ __forceinline__ void operator()(f32x4 (&acc)[2][2][4][2], const Unit& u, int wr, int wc, int fr, int fq) const {
        { const int t_ = lane_id_l(); fr = t_ & 15; fq = t_ >> 4; }
        constexpr int DFF_ = 5632;
        apply_rstd_sb_l<true>(acc, wr, wc, fr, fq, ssl); __builtin_amdgcn_sched_barrier(0);
        const int jl = wc * 32 + 8 * fq, j0 = u.pn * 128 + jl;
        f32x4 wgA[2][3], wuA[2][3];
#pragma unroll
        for (int n = 0; n < 2; ++n)
#pragma unroll
            for (int t = 0; t < 3; ++t) { wgA[n][t] = *(const PG8_LAS f32x4*)(ssl + 2560 + (t * 2) * 128 + jl + 4 * n); wuA[n][t] = *(const PG8_LAS f32x4*)(ssl + 2560 + (t * 2 + 1) * 128 + jl + 4 * n); }
#pragma unroll
        for (int ai = 0; ai < 2; ++ai) { const int s = 2 * ai + wr;
#pragma unroll
            for (int gu = 0; gu < 2; ++gu)
#pragma unroll
                for (int n = 0; n < 2; ++n) {
                    if (fr == 0) *(PG8_LAS f32x4*)(edge + ((s * 2 + 0) * 2 + gu) * 128 + jl + 4 * n) = acc[ai][gu][0][n];
                    if (fr == 15) *(PG8_LAS f32x4*)(edge + ((s * 2 + 1) * 2 + gu) * 128 + jl + 4 * n) = acc[ai][gu][3][n]; } }
        if (wr == 0 && fr == 0) {
#pragma unroll
            for (int m = 0; m < 2; ++m) { float* hp = HALO + ((size_t)(u.pm * 4 + m) * 2) * DFF_ + j0;
#pragma unroll
                for (int gu = 0; gu < 2; ++gu)
#pragma unroll
                    for (int n = 0; n < 2; ++n) *(f32x4*)(hp + (size_t)gu * DFF_ + 4 * n) = acc[0][gu][m][n]; } }
        if (wr == 1 && fr == 15) {
#pragma unroll
            for (int m = 2; m < 4; ++m) { float* hp = HALO + ((size_t)(u.pm * 4 + m) * 2) * DFF_ + j0;
#pragma unroll
                for (int gu = 0; gu < 2; ++gu)
#pragma unroll
                    for (int n = 0; n < 2; ++n) *(f32x4*)(hp + (size_t)gu * DFF_ + 4 * n) = acc[1][gu][m][n]; } }
        if (wr == 0 && wc == 0) { float z_ = 0.f; asm volatile("" : "+v"(z_)); *(PG8_LAS f32x4*)(edge + 2048 + (fq * 16 + fr) * 4) = (f32x4){z_, z_, z_, z_}; }
        asm volatile("s_waitcnt lgkmcnt(0)" ::: "memory"); __builtin_amdgcn_s_barrier(); asm volatile("" ::: "memory");
        const bool f0 = (fr == 0), f15 = (fr == 15);
#define CG_DPP4(dst, src, fn) do { dst[0] = fn(src[0]); dst[1] = fn(src[1]); dst[2] = fn(src[2]); dst[3] = fn(src[3]); } while (0)
#define CG_SEL4(dst, c, a, b) do { dst[0] = (c) ? a[0] : b[0]; dst[1] = (c) ? a[1] : b[1]; dst[2] = (c) ? a[2] : b[2]; dst[3] = (c) ? a[3] : b[3]; } while (0)
#pragma unroll
        for (int ai = 0; ai < 2; ++ai) { const int s = 2 * ai + wr;
            const PG8_LAS float* pa = (s > 0 ? edge + (((s - 1) * 2 + 1) * 2) * 128 : edge + 2048) + jl; const PG8_LAS float* pb = (s < 3 ? edge + (((s + 1) * 2 + 0) * 2) * 128 : edge + 2048) + jl;
            f32x4 eaA[2][2], ebA[2][2];
#pragma unroll
            for (int gu = 0; gu < 2; ++gu)
#pragma unroll
                for (int n = 0; n < 2; ++n) eaA[gu][n] = *(const PG8_LAS f32x4*)(pa + gu * 128 + 4 * n);
#pragma unroll
            for (int m = 0; m < 4; ++m) {
                if (m == 2) {
#pragma unroll
                    for (int gu = 0; gu < 2; ++gu)
#pragma unroll
                        for (int n = 0; n < 2; ++n) ebA[gu][n] = *(const PG8_LAS f32x4*)(pb + gu * 128 + 4 * n); }
                u32x4 w4;
#pragma unroll
                for (int n = 0; n < 2; ++n) {
                    const f32x4* wg = wgA[n]; const f32x4* wu = wuA[n];
                    f32x4 cv[2];
#pragma unroll
                    for (int gu = 0; gu < 2; ++gu) {
                        const f32x4 self = acc[ai][gu][m][n];
                        f32x4 t4, up, dn;
                        if (m == 0) { const f32x4 ea = eaA[gu][n];
                                      up[0] = dpp_shr1_old(ea[0], acc[ai][gu][3][n][0]); up[1] = dpp_shr1_old(ea[1], acc[ai][gu][3][n][1]); up[2] = dpp_shr1_old(ea[2], acc[ai][gu][3][n][2]); up[3] = dpp_shr1_old(ea[3], acc[ai][gu][3][n][3]); }
                        else up = acc[ai][gu][m - 1][n];
                        if (m == 3) { const f32x4 eb = ebA[gu][n];
                                      dn[0] = dpp_shl1_old(eb[0], acc[ai][gu][0][n][0]); dn[1] = dpp_shl1_old(eb[1], acc[ai][gu][0][n][1]); dn[2] = dpp_shl1_old(eb[2], acc[ai][gu][0][n][2]); dn[3] = dpp_shl1_old(eb[3], acc[ai][gu][0][n][3]); }
                        else dn = acc[ai][gu][m + 1][n];
                        const f32x4* w = gu ? wu : wg;
                        cv[gu] = w[0] * up + w[1] * self + w[2] * dn;
                    }
                    const f32x4 ex = cv[0];
                    f32x4 sg; sg[0] = __builtin_amdgcn_exp2f(ex[0]); sg[1] = __builtin_amdgcn_exp2f(ex[1]); sg[2] = __builtin_amdgcn_exp2f(ex[2]); sg[3] = __builtin_amdgcn_exp2f(ex[3]);
                    sg = sg + 1.0f;
                    sg[0] = __builtin_amdgcn_rcpf(sg[0]); sg[1] = __builtin_amdgcn_rcpf(sg[1]); sg[2] = __builtin_amdgcn_rcpf(sg[2]); sg[3] = __builtin_amdgcn_rcpf(sg[3]);
                    const f32x4 o = (cv[0] * sg) * cv[1];
                    w4[2 * n] = cvt_pk_bf16(o[0], o[1]); w4[2 * n + 1] = cvt_pk_bf16(o[2], o[3]);
                }
                const int trow = ai * HALF + wr * 64 + 4 * fr + m;
                if (trow != 0 && trow != 255) *(u32x4*)(ACT + (size_t)(u.pm * BM + trow) * DFF_ + j0) = w4;
            }
        }
#undef CG_DPP4
#undef CG_SEL4
    }
};

struct EpiScIn {
    static constexpr bool PREF = true , PERM = true, AFTER_DRAIN = false, APERM = true, RELAX = true;
    bf16_t* BB; bf16_t* O; float* HALO; const float* cw; PG8_LAS float* edge; const float* SS; const float* sb; PG8_LAS float* ssl;
    __device__ __forceinline__ void pref_issue(const Unit& u, int wid) const { const int lane = lane_id_l();     ss_pref_issue(u, wid, lane, SS, sb, SB_LD, ssl);
        const int q = u.pn / 3, kind = u.pn - 3 * q;
        if (kind != 0 && (wid == 1 || wid == 2)) { const int r = 2 * (wid - 1) + (lane >> 5);
            if (r < 3) __builtin_amdgcn_global_load_lds((const unsigned*)(cw + (size_t)r * 2048 + q * 256 + (kind - 1) * 128 + (lane & 31) * 4), (PG8_LAS unsigned*)(ssl + 2560 + (wid - 1) * 256), 16, 0, 0); } }
    __device__ __forceinline__ void pref_reduce(int wid) const { const int tid = wid * 64 + lane_id_l(); ss_pref_reduce(tid, ssl); }
    __device__ __forceinline__ void operator()(f32x4 (&acc)[2][2][4][2], const Unit& u, int wr, int wc, int fr, int fq) const {
        { const int t_ = lane_id_l(); fr = t_ & 15; fq = t_ >> 4; }
        constexpr int LD = 2048;
        apply_rstd_sb_l<true>(acc, wr, wc, fr, fq, ssl); __builtin_amdgcn_sched_barrier(0);
        { const int t_ = lane_id_l(); fr = t_ & 15; fq = t_ >> 4; }
        const int q = u.pn / 3; int kind = u.pn - 3 * q;
        if (kind == 0) {
            const int col0 = q * 256 + wc * 32 + 8 * fq;
#pragma unroll
            for (int ai = 0; ai < 2; ++ai)
#pragma unroll
                for (int m = 0; m < 4; ++m) { bf16_t* rowp = BB + (size_t)(u.pm * BM + ai * HALF + wr * 64 + 4 * fr + m) * LD + col0;
#pragma unroll
                    for (int bj = 0; bj < 2; ++bj) { const f32x4 v0 = acc[ai][bj][m][0], v1 = acc[ai][bj][m][1];
                        u32x4 w; w.x = cvt_pk_bf16(v0[0], v0[1]); w.y = cvt_pk_bf16(v0[2], v0[3]); w.z = cvt_pk_bf16(v1[0], v1[1]); w.w = cvt_pk_bf16(v1[2], v1[3]);
                        *(u32x4*)(rowp + bj * HALF) = w; } }
        }
        asm volatile("" : "+s"(kind) :: "memory");
        if (kind == 0) return;
        const int jl = wc * 32 + 8 * fq, j0 = q * 256 + (kind - 1) * 128 + jl;
#pragma unroll
        for (int ai = 0; ai < 2; ++ai)
#pragma unroll
            for (int m = 0; m < 4; ++m)
#pragma unroll
                for (int n = 0; n < 2; ++n) acc[ai][0][m][n] = acc[ai][0][m][n] * acc[ai][1][m][n];
#pragma unroll
        for (int ai = 0; ai < 2; ++ai)
            asm volatile("" : "+v"(acc[ai][0][0][0]), "+v"(acc[ai][0][0][1]), "+v"(acc[ai][0][1][0]), "+v"(acc[ai][0][1][1]), "+v"(acc[ai][0][2][0]), "+v"(acc[ai][0][2][1]), "+v"(acc[ai][0][3][0]), "+v"(acc[ai][0][3][1]) :: "memory");
        __builtin_amdgcn_sched_barrier(0);
        f32x4 wt[2][3]; u32x4 bb[2][4];
#pragma unroll
        for (int n = 0; n < 2; ++n)
#pragma unroll
            for (int t = 0; t < 3; ++t) wt[n][t] = *(const PG8_LAS f32x4*)(ssl + 2560 + t * 128 + jl + 4 * n);
#pragma unroll
        for (int ai = 0; ai < 2; ++ai)
#pragma unroll
            for (int m = 0; m < 4; ++m) bb[ai][m] = *(const u32x4*)(BB + (size_t)(u.pm * BM + ai * HALF + wr * 64 + 4 * fr + m) * LD + j0);
#pragma unroll
        for (int ai = 0; ai < 2; ++ai) { const int s = 2 * ai + wr;
#pragma unroll
            for (int n = 0; n < 2; ++n) {
                if (fr == 0) *(PG8_LAS f32x4*)(edge + (s * 2 + 0) * 128 + jl + 4 * n) = acc[ai][0][0][n];
                if (fr == 15) *(PG8_LAS f32x4*)(edge + (s * 2 + 1) * 128 + jl + 4 * n) = acc[ai][0][3][n]; } }
        if (wr == 0 && fr == 0) {
#pragma unroll
            for (int m = 0; m < 2; ++m)
#pragma unroll
                for (int n = 0; n < 2; ++n) *(f32x4*)(HALO + (size_t)(u.pm * 4 + m) * LD + j0 + 4 * n) = acc[0][0][m][n]; }
        if (wr == 1 && fr == 15) {
#pragma unroll
            for (int m = 2; m < 4; ++m)
#pragma unroll
                for (int n = 0; n < 2; ++n) *(f32x4*)(HALO + (size_t)(u.pm * 4 + m) * LD + j0 + 4 * n) = acc[1][0][m][n]; }
        if (wr == 0 && wc == 0) { float z_ = 0.f; asm volatile("" : "+v"(z_)); *(PG8_LAS f32x4*)(edge + 2048 + (fq * 16 + fr) * 4) = (f32x4){z_, z_, z_, z_}; }
        asm volatile("s_waitcnt lgkmcnt(0)" ::: "memory"); __builtin_amdgcn_s_barrier(); asm volatile("" ::: "memory");
        const bool f0 = (fr == 0), f15 = (fr == 15);
#define SC_DPP4(dst, src, fn) do { dst[0] = fn(src[0]); dst[1] = fn(src[1]); dst[2] = fn(src[2]); dst[3] = fn(src[3]); } while (0)
#define SC_SEL4(dst, c, a, b) do { dst[0] = (c) ? a[0] : b[0]; dst[1] = (c) ? a[1] : b[1]; dst[2] = (c) ? a[2] : b[2]; dst[3] = (c) ? a[3] : b[3]; } while (0)
#pragma unroll
        for (int ai = 0; ai < 2; ++ai) { const int s = 2 * ai + wr;
            const PG8_LAS float* pa = (s > 0 ? edge + ((s - 1) * 2 + 1) * 128 : edge + 2048) + jl; const PG8_LAS float* pb = (s < 3 ? edge + ((s + 1) * 2 + 0) * 128 : edge + 2048) + jl;
            f32x4 eaA[2], ebA[2];
#pragma unroll
            for (int n = 0; n < 2; ++n) { eaA[n] = *(const PG8_LAS f32x4*)(pa + 4 * n); ebA[n] = *(const PG8_LAS f32x4*)(pb + 4 * n); }
#pragma unroll
            for (int m = 0; m < 4; ++m) {
                u32x4 w4;
#pragma unroll
                for (int n = 0; n < 2; ++n) {
                    const f32x4 self = acc[ai][0][m][n];
                    f32x4 t4, up, dn;
                    if (m == 0) { const f32x4 ea = eaA[n];
                                  up[0] = dpp_shr1_old(ea[0], acc[ai][0][3][n][0]); up[1] = dpp_shr1_old(ea[1], acc[ai][0][3][n][1]); up[2] = dpp_shr1_old(ea[2], acc[ai][0][3][n][2]); up[3] = dpp_shr1_old(ea[3], acc[ai][0][3][n][3]); }
                    else up = acc[ai][0][m - 1][n];
                    if (m == 3) { const f32x4 eb = ebA[n];
                                  dn[0] = dpp_shl1_old(eb[0], acc[ai][0][0][n][0]); dn[1] = dpp_shl1_old(eb[1], acc[ai][0][0][n][1]); dn[2] = dpp_shl1_old(eb[2], acc[ai][0][0][n][2]); dn[3] = dpp_shl1_old(eb[3], acc[ai][0][0][n][3]); }
                    else dn = acc[ai][0][m + 1][n];
                    const f32x4 cv = wt[n][0] * up + wt[n][1] * self + wt[n][2] * dn;
                    const unsigned b0 = bb[ai][m][2 * n], b1 = bb[ai][m][2 * n + 1];
                    const f32x4 bv = (f32x4){__uint_as_float(b0 << 16), __uint_as_float(b0 & 0xffff0000u), __uint_as_float(b1 << 16), __uint_as_float(b1 & 0xffff0000u)};
                    const f32x4 o = cv * bv;
                    w4[2 * n] = cvt_pk_bf16(o[0], o[1]); w4[2 * n + 1] = cvt_pk_bf16(o[2], o[3]);
                }
                const int trow = ai * HALF + wr * 64 + 4 * fr + m;
                if (trow != 0 && trow != 255) *(u32x4*)(O + (size_t)(u.pm * BM + trow) * LD + j0) = w4;
            }
        }
#undef SC_DPP4
#undef SC_SEL4
    }
};
struct OrderSB {
    static constexpr bool SPLIT = false;
    int set, G, c;
    __device__ __forceinline__ void init(int set_, int c_, int G_) { set = set_; c = c_; G = G_; }
    __device__ __forceinline__ bool next(int i, Unit& u) const {
        const int uu = i * G + c; constexpr int T_IN = NSBT_IN, T_SC = NSBT_SC, T_UP = NSBT_UP;
        const int pn = uu < T_IN ? set * T_IN + uu : (uu < T_IN + T_SC ? 2 * T_IN + set * T_SC + (uu - T_IN) : 2 * T_IN + 2 * T_SC + set * 2 * T_UP + (uu - T_IN - T_SC));
        u.pm = 0; u.pn = pn; u.kb = 0; u.nt = 0; return uu < T_IN + T_SC + 2 * T_UP;
    }
    __device__ __forceinline__ void a_ready(const Unit&) const {}
    __device__ __forceinline__ void done(const Unit&) const {}
};
struct OrderSc {
    static constexpr bool SPLIT = false;
    int nMv, nsu, G, c, latent;
    __device__ __forceinline__ void init(int nMv_, int G_, int c_, int latent_) { nMv = nMv_; nsu = nMv_ * 8; G = G_; c = c_; latent = latent_; }
    __device__ __forceinline__ bool next(int i, Unit& u) const {
        const int si = i / 3, sub = i - 3 * si;
        const long L = (long)si * G + c; if (L >= nsu) return false;
        int wgid = (int)L; { const int q = nsu / NXCD, r = nsu % NXCD, xcd = wgid % NXCD, off = wgid / NXCD; wgid = (xcd < r ? xcd * (q + 1) : r * (q + 1) + (xcd - r) * q) + off; }
        const int nig = WGM * 8, gid = wgid / nig, fm = gid * WGM, gsz = (nMv - fm) < WGM ? (nMv - fm) : WGM;
        const int v = fm + ((wgid % nig) % gsz), q8 = (wgid % nig) / gsz;
        u.pm = latent ? v + (v >> 4) + 1 : v; u.pn = 3 * q8 + sub; u.kb = 0; u.nt = 0; return true;
    }
    __device__ __forceinline__ void a_ready(const Unit&) const {}
    __device__ __forceinline__ void done(const Unit&) const {}
};
struct OrderSplit {
    static constexpr bool SPLIT = true;
    int nN, nfull, G, c, ntf, nctx;
    __device__ __forceinline__ void init(int nN_, int G_, int c_, int ntf_, int nctx_) { nN = nN_; nfull = 128 * nN_; G = G_; c = c_; ntf = ntf_; nctx = nctx_; }
    __device__ __forceinline__ bool next(int i, Unit& u) const {
        const long L = (long)i * G + c;
        if (L >= nfull + (long)nctx * nN * 4) return false;
        const bool full = L < nfull;
        int wgid = (int)L; { const int q = nfull / NXCD, r = nfull % NXCD, xcd = wgid % NXCD, off = wgid / NXCD; wgid = (xcd < r ? xcd * (q + 1) : r * (q + 1) + (xcd - r) * q) + off; }
        const int nig = WGM * nN, gid = wgid / nig, fm = gid * WGM, v = fm + ((wgid % nig) % WGM);
        const int q = (int)(L - nfull), s = q & 3, cu = q >> 2;
        const int pm = full ? v + (v >> 4) + 1 : 17 * (cu & 7), pn = full ? (wgid % nig) / WGM : cu >> 3, nt_ = full ? ntf : (ntf >> 2), kb = full ? 0 : s * (ntf >> 2);
        u.pm = pm; u.pn = pn; u.kb = kb; u.nt = nt_; return true;
    }
    __device__ __forceinline__ void a_ready(const Unit&) const {}
    __device__ __forceinline__ void done(const Unit&) const {}
};
struct Order {
    static constexpr bool SPLIT = false;
    int nMv, nN, nwg, G, c, latent, voff;
    __device__ __forceinline__ void init(int nMv_, int nN_, int G_, int c_, int latent_, int voff_) { nMv = nMv_; nN = nN_; nwg = nMv_ * nN_; G = G_; c = c_; latent = latent_; voff = voff_; }
    __device__ __forceinline__ bool next(int i, Unit& u) const {
        const long L = (long)i * G + c; if (L >= nwg) return false;
        int wgid = (int)L; { const int q = nwg / NXCD, r = nwg % NXCD, xcd = wgid % NXCD, off = wgid / NXCD; wgid = (xcd < r ? xcd * (q + 1) : r * (q + 1) + (xcd - r) * q) + off; }
        const int nig = WGM * nN, gid = wgid / nig, fm = gid * WGM, gsz = (nMv - fm) < WGM ? (nMv - fm) : WGM;
        const int v = fm + ((wgid % nig) % gsz) + voff; u.pn = (wgid % nig) / gsz;
        u.pm = latent ? v + (v >> 4) + 1 : v; u.kb = 0; u.nt = 0; return true;
    }
    __device__ __forceinline__ void a_ready(const Unit&) const {}
    __device__ __forceinline__ void done(const Unit&) const {}
};
template <class Epi, class Sched, bool ALIGN_EPI = false, bool SP2 = false>
__device__ __forceinline__ void gemm_phase(PG8_LAS unsigned char* lds, const Gemm g, const Sched& S, const Epi& E, const int wave_in) {
    int tid_l = wave_in * 64 + lane_id_l(); asm volatile("" : "+v"(tid_l));
    const int tid = tid_l, wid = __builtin_amdgcn_readfirstlane(tid >> 6), lane = tid & 63, wr = wid >> 2, wc = wid & 3, fr = lane & 15, fq = lane >> 4;
    const int K = g.K; int nt = K / BK;
    unsigned voffA[2], voffB[2];
#pragma unroll
    for (int i = 0; i < 2; ++i) { int R, C; stage_rc(tid * 16 + i * 8192, R, C); const int Rb = Epi::PERM ? ((R & ~31) + perm32(R & 31)) : R;
        const int Ra = Epi::APERM ? ((R & 64) | (4 * (R & 15) + ((R >> 4) & 3))) : R;
        voffA[i] = (unsigned)(Ra * K + C) * 2u; voffB[i] = (unsigned)(Rb * K + C) * 2u; }
    const size_t kstep = (size_t)(BK * 2);
    const size_t hstep = (size_t)HALF * K * 2;
    const size_t tstep = 2 * hstep;
    const unsigned ldsw = (unsigned)wid * 1024u;
    const int aoff = lds_byte(wr * 64 + fr, fq * 8), boff = lds_byte(wc * 32 + fr, fq * 8);
#define PG8_SA(b, h) (((b) * 2 + (h)) * HTB)
#define PG8_SB(b, h) ((4 + (b) * 2 + (h)) * HTB)
#define PG8_STAGE(bufoff, gbase, voff) do { _Pragma("unroll") for (int _i = 0; _i < 2; ++_i) \
        __builtin_amdgcn_global_load_lds((const unsigned*)((const char*)(gbase) + (voff)[_i]), (PG8_LAS unsigned*)(lds + (bufoff) + ldsw + _i * 8192), 16, 0, 0); } while (0)
#define PG8_LDA(dst, b, h) do { _Pragma("unroll") for (int m = 0; m < 4; ++m) _Pragma("unroll") for (int k = 0; k < 2; ++k) dst[m][k] = *(const PG8_LAS bf16x8*)(lds + PG8_SA(b, h) + aoff + m * 2048 + k * 1024); } while (0)
#define PG8_LDB(dst, b, h) do { _Pragma("unroll") for (int n = 0; n < 2; ++n) _Pragma("unroll") for (int k = 0; k < 2; ++k) dst[n][k] = *(const PG8_LAS bf16x8*)(lds + PG8_SB(b, h) + boff + n * 2048 + k * 1024); } while (0)
#define PG8_MMA(ai, bj, At, Bt) do { __builtin_amdgcn_s_setprio(1); _Pragma("unroll") for (int m = 0; m < 4; ++m) _Pragma("unroll") for (int n = 0; n < 2; ++n) _Pragma("unroll") for (int k = 0; k < 2; ++k) \
        acc[ai][bj][m][n] = __builtin_amdgcn_mfma_f32_16x16x32_bf16(Bt[n][k], At[m][k], acc[ai][bj][m][n], 0, 0, 0); __builtin_amdgcn_s_setprio(0); } while (0)
#define PG8_WAIT_V(n) asm volatile("s_waitcnt vmcnt(" #n ")" ::: "memory")
#define PG8_WAIT_L(n) asm volatile("s_waitcnt lgkmcnt(" #n ")" ::: "memory")
#define PG8_BAR __builtin_amdgcn_s_barrier()
#define PG8_SCHED __builtin_amdgcn_sched_barrier(0)
    Unit cur, nxt; int ui = 0;
    if (!S.next(0, cur)) return;
    if constexpr (Sched::SPLIT) nt = cur.nt;
    f32x4 acc[2][2][4][2];
#pragma unroll
    for (int a = 0; a < 2; ++a)
#pragma unroll
        for (int b = 0; b < 2; ++b)
#pragma unroll
            for (int m = 0; m < 4; ++m)
#pragma unroll
                for (int n = 0; n < 2; ++n) acc[a][b][m][n] = (f32x4){0.f, 0.f, 0.f, 0.f};
    bf16x8 At[4][2], B0[2][2], B1[2][2];
    const char* cA = (const char*)g.A + (size_t)cur.pm * tstep; const char* cB = (const char*)g.Bt + (size_t)cur.pn * tstep;
    if constexpr (Sched::SPLIT) { cA += (size_t)cur.kb * kstep; cB += (size_t)cur.kb * kstep; }
    S.a_ready(cur);
    if constexpr (SP2) {
        PG8_STAGE(PG8_SB(0, 0), cB, voffB); PG8_STAGE(PG8_SB(0, 1), cB + hstep, voffB); PG8_STAGE(PG8_SA(0, 0), cA, voffA); PG8_STAGE(PG8_SA(0, 1), cA + hstep, voffA);
        if (wr == 1) PG8_BAR;
        PG8_WAIT_V(2); PG8_BAR;
        PG8_STAGE(PG8_SB(1, 0), cB + kstep, voffB); PG8_STAGE(PG8_SA(1, 0), cA + kstep, voffA); PG8_STAGE(PG8_SB(1, 1), cB + hstep + kstep, voffB);
        PG8_WAIT_V(6); PG8_BAR;
    } else {
        PG8_STAGE(PG8_SB(0, 0), cB, voffB); PG8_STAGE(PG8_SA(0, 0), cA, voffA); PG8_STAGE(PG8_SB(0, 1), cB + hstep, voffB); PG8_STAGE(PG8_SA(0, 1), cA + hstep, voffA);
        if (wr == 1) PG8_BAR;
        PG8_WAIT_V(4); PG8_BAR;
        PG8_STAGE(PG8_SB(1, 0), cB + kstep, voffB); PG8_STAGE(PG8_SA(1, 0), cA + kstep, voffA); PG8_STAGE(PG8_SB(1, 1), cB + hstep + kstep, voffB);
        PG8_WAIT_V(6); PG8_BAR;
    }
    for (;;) {
        const bool has_next = S.next(ui + 1, nxt);
        const char* nA = has_next ? (const char*)g.A + (size_t)nxt.pm * tstep : cA; const char* nB = has_next ? (const char*)g.Bt + (size_t)nxt.pn * tstep : cB;
        if constexpr (Sched::SPLIT) { if (has_next) { nA += (size_t)nxt.kb * kstep; nB += (size_t)nxt.kb * kstep; } }
        for (int t = 0; t < nt; t += 2) {
            const bool last = (t == nt - 2);
            const char* a1 = cA + (size_t)(t + 1) * kstep;
            const char* a2 = last ? nA : cA + (size_t)(t + 2) * kstep; const char* b2 = last ? nB : cB + (size_t)(t + 2) * kstep;
            const char* a3 = a2 + kstep; const char* b3 = b2 + kstep;
            if (last && has_next) S.a_ready(nxt);
            if constexpr (Epi::PREF) { if (t == 2) E.pref_issue(cur, wid); else if (t == 4) E.pref_reduce(wid); }
            if constexpr (SP2) {
            PG8_LDB(B0, 0, 0); PG8_LDB(B1, 0, 1); PG8_SCHED; PG8_LDA(At, 0, 0); PG8_STAGE(PG8_SA(1, 1), a1 + hstep, voffA);
            PG8_WAIT_V(8); PG8_WAIT_L(0); PG8_BAR; PG8_MMA(0, 0, At, B0); PG8_MMA(0, 1, At, B1); PG8_BAR; PG8_SCHED;
            PG8_LDA(At, 0, 1); PG8_STAGE(PG8_SB(0, 0), b2, voffB); PG8_STAGE(PG8_SB(0, 1), b2 + hstep, voffB); PG8_STAGE(PG8_SA(0, 0), a2, voffA);
            PG8_WAIT_V(8); PG8_WAIT_L(0); PG8_BAR; PG8_MMA(1, 0, At, B0); PG8_MMA(1, 1, At, B1); PG8_BAR; PG8_SCHED;
            PG8_LDB(B0, 1, 0); PG8_LDB(B1, 1, 1); PG8_SCHED; PG8_LDA(At, 1, 0); PG8_STAGE(PG8_SA(0, 1), a2 + hstep, voffA);
            PG8_WAIT_V(8); PG8_WAIT_L(0); PG8_BAR; PG8_MMA(0, 0, At, B0); PG8_MMA(0, 1, At, B1); PG8_BAR; PG8_SCHED;
            PG8_LDA(At, 1, 1); PG8_STAGE(PG8_SB(1, 0), b3, voffB); PG8_STAGE(PG8_SB(1, 1), b3 + hstep, voffB); PG8_STAGE(PG8_SA(1, 0), a3, voffA);
            PG8_WAIT_V(8); PG8_WAIT_L(0); PG8_BAR; PG8_MMA(1, 0, At, B0); PG8_MMA(1, 1, At, B1); PG8_BAR; PG8_SCHED;
            } else {
            PG8_LDB(B0, 0, 0); PG8_SCHED; PG8_LDA(At, 0, 0); PG8_STAGE(PG8_SA(1, 1), a1 + hstep, voffA);
            PG8_WAIT_L(8); PG8_BAR; PG8_WAIT_L(0); PG8_MMA(0, 0, At, B0); PG8_BAR; PG8_SCHED;
            PG8_LDB(B1, 0, 1); PG8_STAGE(PG8_SB(0, 0), b2, voffB);
            PG8_BAR; PG8_WAIT_L(0); PG8_MMA(0, 1, At, B1); PG8_BAR;
            PG8_LDA(At, 0, 1); PG8_STAGE(PG8_SA(0, 0), a2, voffA);
            PG8_BAR; PG8_WAIT_L(0); PG8_MMA(1, 0, At, B0); PG8_BAR; PG8_SCHED;
            PG8_STAGE(PG8_SB(0, 1), b2 + hstep, voffB);
            PG8_WAIT_V(6); PG8_BAR; PG8_MMA(1, 1, At, B1); PG8_BAR;
            PG8_LDB(B0, 1, 0); PG8_SCHED; PG8_LDA(At, 1, 0); PG8_STAGE(PG8_SA(0, 1), a2 + hstep, voffA);
            PG8_WAIT_L(8); PG8_BAR; PG8_WAIT_L(0); PG8_MMA(0, 0, At, B0); PG8_BAR; PG8_SCHED;
            PG8_LDB(B1, 1, 1); PG8_STAGE(PG8_SB(1, 0), b3, voffB);
            PG8_BAR; PG8_WAIT_L(0); PG8_MMA(0, 1, At, B1); PG8_BAR;
            PG8_LDA(At, 1, 1); PG8_STAGE(PG8_SA(1, 0), a3, voffA);
            PG8_BAR; PG8_WAIT_L(0); PG8_MMA(1, 0, At, B0); PG8_BAR; PG8_SCHED;
            PG8_STAGE(PG8_SB(1, 1), b3 + hstep, voffB);
            PG8_WAIT_V(6); PG8_BAR; PG8_MMA(1, 1, At, B1); PG8_BAR;
            }
        }
        if constexpr (ALIGN_EPI) { if (wr == 0) PG8_BAR; }
        if constexpr (!Epi::AFTER_DRAIN) { E(acc, cur, wr, wc, fr, fq); S.done(cur); }
        if (!has_next) break;
#pragma unroll
        for (int a = 0; a < 2; ++a)
#pragma unroll
            for (int b = 0; b < 2; ++b)
#pragma unroll
                for (int m = 0; m < 4; ++m)
#pragma unroll
                    for (int n = 0; n < 2; ++n) acc[a][b][m][n] = (f32x4){0.f, 0.f, 0.f, 0.f};
        cur = nxt; cA = nA; cB = nB; ++ui;
        if constexpr (Sched::SPLIT) nt = cur.nt;
        if constexpr (ALIGN_EPI) { if (wr == 1) PG8_BAR; }
    }
    PG8_WAIT_V(0);
    if constexpr (!ALIGN_EPI) { if (wr == 0) PG8_BAR; }
    PG8_BAR;
    if constexpr (Epi::AFTER_DRAIN) { E.fused(acc, cur, wr, wc, fr, fq, lds, wid, lane); S.done(cur); }
#undef PG8_SA
#undef PG8_SB
#undef PG8_STAGE
#undef PG8_LDA
#undef PG8_LDB
#undef PG8_MMA
#undef PG8_WAIT_V
#undef PG8_WAIT_L
#undef PG8_BAR
#undef PG8_SCHED
}
}

namespace att {
typedef unsigned short bf16_t;
using bf16x8 = __attribute__((ext_vector_type(8))) short;
using s16x4  = __attribute__((ext_vector_type(4))) short;
using f32x16 = __attribute__((ext_vector_type(16))) float;
using u32x4  = __attribute__((ext_vector_type(4))) unsigned;
constexpr int NW = 8, QBLK = 32, KVBLK = 64, DV = 128;
constexpr int SHM_V = KVBLK * DV * 2;
constexpr float THR = 8.f;
#define ATT_SBAR() __builtin_amdgcn_sched_barrier(0)
__device__ __forceinline__ int crow(int r, int hi) { return (r & 3) + 8 * (r >> 2) + 4 * hi; }
__device__ __forceinline__ unsigned cvtpk(float lo, float hi) { unsigned r; asm volatile("v_cvt_pk_bf16_f32 %0, %1, %2" : "=v"(r) : "v"(lo), "v"(hi)); return r; }
template <int DQK> __device__ __forceinline__ int kswz(int row, int colB) { return row * (DQK * 2) + (colB ^ ((DQK == 128 ? (row & 15) : ((row >> 1) & 7)) << 4)); }

__device__ __forceinline__ void partialSM(f32x16& p0, f32x16& p1, float& m_reg, float& mn, float& alpha, const float C, const float thr_raw) {
  float pmax = p0[0];
#pragma unroll
  for (int r = 1; r < 16; ++r) pmax = fmaxf(pmax, p0[r]);
#pragma unroll
  for (int r = 0; r < 16; ++r) pmax = fmaxf(pmax, p1[r]);
  { auto rr = __builtin_amdgcn_permlane32_swap(__float_as_uint(pmax), __float_as_uint(pmax), false, false);
    pmax = fmaxf(__uint_as_float(rr[0]), __uint_as_float(rr[1])); }
  if (__builtin_expect(__all(pmax - m_reg <= thr_raw), 1)) { mn = m_reg; alpha = 1.f; }
  else { mn = fmaxf(m_reg, pmax); alpha = __builtin_amdgcn_exp2f((m_reg - mn) * C); m_reg = mn; }
  const float mnC = -mn * C;
#pragma unroll
  for (int r = 0; r < 16; ++r) p0[r] = fmaf(p0[r], C, mnC);
#pragma unroll
  for (int r = 0; r < 16; ++r) p1[r] = fmaf(p1[r], C, mnC);
#pragma unroll
  for (int r = 0; r < 16; ++r) p0[r] = __builtin_amdgcn_exp2f(p0[r]);
}
__device__ __forceinline__ void finishSM(f32x16& p0, f32x16& p1, float alpha, float& l_reg, bf16x8& pa0, bf16x8& pa1, bf16x8& pa2, bf16x8& pa3) {
#pragma unroll
  for (int r = 0; r < 16; ++r) p1[r] = __builtin_amdgcn_exp2f(p1[r]);
  float ps = 0;
#pragma unroll
  for (int r = 0; r < 16; ++r) ps += p0[r];
#pragma unroll
  for (int r = 0; r < 16; ++r) ps += p1[r];
  { auto rr = __builtin_amdgcn_permlane32_swap(__float_as_uint(ps), __float_as_uint(ps), false, false);
    ps = __uint_as_float(rr[0]) + __uint_as_float(rr[1]); }
  l_reg = l_reg * alpha + ps;
#define ATT_PK4(P, BASE, OUT) do { unsigned a0 = cvtpk(P[BASE + 0], P[BASE + 1]), a1 = cvtpk(P[BASE + 2], P[BASE + 3]);   \
    unsigned b0 = cvtpk(P[BASE + 4], P[BASE + 5]), b1 = cvtpk(P[BASE + 6], P[BASE + 7]);                              \
    auto r0 = __builtin_amdgcn_permlane32_swap(a0, b0, false, false); auto r1 = __builtin_amdgcn_permlane32_swap(a1, b1, false, false); \
    u32x4 w = {r0[0], r1[0], r0[1], r1[1]}; OUT = *reinterpret_cast<bf16x8*>(&w); } while (0)
  ATT_PK4(p0, 0, pa0); ATT_PK4(p0, 8, pa1); ATT_PK4(p1, 0, pa2); ATT_PK4(p1, 8, pa3);
#undef ATT_PK4
}
template <int DQK>
__device__ __forceinline__ void qkt(f32x16& p0, f32x16& p1, const char* Ks, const bf16x8* qr, int r32, int hi) {
  p0 = f32x16{}; p1 = f32x16{};
#pragma unroll
  for (int d0 = 0; d0 < DQK / 16; ++d0) { const int cb = (d0 * 16 + hi * 8) * 2;
    const bf16x8 b0 = *reinterpret_cast<const bf16x8*>(Ks + kswz<DQK>(r32, cb));
    const bf16x8 b1 = *reinterpret_cast<const bf16x8*>(Ks + kswz<DQK>(32 + r32, cb));
    p0 = __builtin_amdgcn_mfma_f32_32x32x16_bf16(b0, qr[d0], p0, 0, 0, 0);
    p1 = __builtin_amdgcn_mfma_f32_32x32x16_bf16(b1, qr[d0], p1, 0, 0, 0); }
}
__device__ __forceinline__ int v_st(int k, int c) { const int kk = (k & ~0xC) | ((k & 4) << 1) | ((k & 8) >> 1); return ((kk >> 3) * 4 + (c >> 5)) * 512 + ((kk & 7) * 32 + (c & 31)) * 2; }
__device__ __forceinline__ int v_rd_base(int lane) { return ((lane & 3) << 3) | (((lane >> 2) & 3) << 6) | (((lane >> 4) & 1) << 5) | (((lane >> 5) & 1) << 8); }
constexpr int v_rd_off(int d0, int ks, int half) { return d0 * 512 + ks * 4096 + half * 2048; }
template <int OFF> __device__ __forceinline__ s16x4 tr_read(int vb) {
  s16x4 r; asm volatile("ds_read_b64_tr_b16 %0, %1 offset:%2" : "=&v"(r) : "v"(vb), "i"(OFF) : "memory"); return r;
}
template <int D0> __device__ __forceinline__ void pv_one(f32x16& od, int vb, bf16x8 pa0, bf16x8 pa1, bf16x8 pa2, bf16x8 pa3) {
  const s16x4 l0 = tr_read<v_rd_off(D0, 0, 0)>(vb), h0 = tr_read<v_rd_off(D0, 0, 1)>(vb), l1 = tr_read<v_rd_off(D0, 1, 0)>(vb), h1 = tr_read<v_rd_off(D0, 1, 1)>(vb);
  const s16x4 l2 = tr_read<v_rd_off(D0, 2, 0)>(vb), h2 = tr_read<v_rd_off(D0, 2, 1)>(vb), l3 = tr_read<v_rd_off(D0, 3, 0)>(vb), h3 = tr_read<v_rd_off(D0, 3, 1)>(vb);
  asm volatile("s_waitcnt lgkmcnt(0)" ::: "memory"); ATT_SBAR();
#define ATT_PK(L, H) (bf16x8){L[0], L[1], L[2], L[3], H[0], H[1], H[2], H[3]}
  od = __builtin_amdgcn_mfma_f32_32x32x16_bf16(pa0, ATT_PK(l0, h0), od, 0, 0, 0);
  od = __builtin_amdgcn_mfma_f32_32x32x16_bf16(pa1, ATT_PK(l1, h1), od, 0, 0, 0);
  od = __builtin_amdgcn_mfma_f32_32x32x16_bf16(pa2, ATT_PK(l2, h2), od, 0, 0, 0);
  od = __builtin_amdgcn_mfma_f32_32x32x16_bf16(pa3, ATT_PK(l3, h3), od, 0, 0, 0);
#undef ATT_PK
}
__device__ __forceinline__ void pv_d0(f32x16* o, int vb, bf16x8 pa0, bf16x8 pa1, bf16x8 pa2, bf16x8 pa3) {
  pv_one<0>(o[0], vb, pa0, pa1, pa2, pa3); pv_one<1>(o[1], vb, pa0, pa1, pa2, pa3); pv_one<2>(o[2], vb, pa0, pa1, pa2, pa3); pv_one<3>(o[3], vb, pa0, pa1, pa2, pa3);
}
__device__ __forceinline__ bf16x8 ld8(const bf16_t* p) { return *reinterpret_cast<const bf16x8*>(p); }

template <int DQK, int SDEPTH, int LDQ, int LDK, int LDV, int LDO>
__device__ __forceinline__ void attn_unit(const bf16_t* __restrict__ Qb, const bf16_t* __restrict__ Kh, const bf16_t* __restrict__ Kr,
                                          const bf16_t* __restrict__ Vh, bf16_t* __restrict__ Ob, int seq, float scale, char* lds, const int wave_in, const float* ropeB, const int pos0, const float* qnw) {
  constexpr int SHM_K = KVBLK * DQK * 2, NQ = DQK / 16;
  int tid_l = wave_in * 64 + pg8::lane_id_l(); asm volatile("" : "+v"(tid_l));
  const int tid = tid_l, wid = __builtin_amdgcn_readfirstlane(tid >> 6), lane = tid & 63, r32 = lane & 31, hi = lane >> 5;
  char* V_lds = lds; char* K_lds = lds + 2 * SHM_V;
  float* ws = (float*)(lds + 2 * SHM_V + 2 * SHM_K) + wid * 64; float* li_l = ws; float* al_l = ws + 32;
  const float C = scale * 1.4426950408889634f, thr_raw = THR / scale;
  float m_reg = -1e30f, l_reg = 0; f32x16 o[4] = {}; bf16x8 qr[NQ];
  const bf16_t* Qw = Qb + (long)(wid * QBLK) * LDQ + (unsigned)(r32 * LDQ + hi * 8);
#pragma unroll
  for (int d0 = 0; d0 < NQ; ++d0) qr[d0] = ld8(Qw + d0 * 16);
  typedef float f32x4_t __attribute__((ext_vector_type(4)));
  f32x4_t cr[4], cc[4];
  if constexpr (DQK == 192) {
    const int pos = (pos0 >= 0 ? pos0 : 0) + wid * QBLK + r32; const float* tr = ropeB + ((pos >> 6) * 16 + hi * 8) * 2; const float* tc = ropeB + ((pos & 63) * 16 + hi * 8) * 2;
#pragma unroll
    for (int i = 0; i < 4; ++i) { cr[i] = *(const f32x4_t*)(tr + 4 * i); cc[i] = *(const f32x4_t*)(tc + 4 * i); }
  }
  const int sr = tid >> 4, sc = (tid & 15) * 8, vst0 = v_st(sr, sc), vst1 = v_st(32 + sr, sc);
  const int krr = tid >> 3, krc = (tid & 7) * 8;
  const int vb0 = (int)(uintptr_t)V_lds + v_rd_base(lane);
  struct { bf16x8 vs0, vs1, ks0, ks1, ks2; } sr_[SDEPTH];
  const unsigned offV = (unsigned)(sr * LDV + sc), offK = (unsigned)(sr * LDK + sc), offR = (unsigned)(krr * 64 + krc);
#define ATT_SLOAD(i, k0) do { const bf16_t* Vt_ = Vh + (long)(k0) * LDV; const bf16_t* Kt_ = Kh + (long)(k0) * LDK; \
    sr_[i].vs0 = ld8(Vt_ + offV); sr_[i].vs1 = ld8(Vt_ + 32 * LDV + offV); sr_[i].ks0 = ld8(Kt_ + offK); sr_[i].ks1 = ld8(Kt_ + 32 * LDK + offK); \
    if constexpr (DQK == 192) sr_[i].ks2 = ld8(Kr + (long)(k0) * 64 + offR); } while (0)
#define ATT_SWRITE(b, i) do { *(bf16x8*)(V_lds + (b) * SHM_V + vst0) = sr_[i].vs0;          \
    *(bf16x8*)(V_lds + (b) * SHM_V + vst1) = sr_[i].vs1; const int kc_ = sc * 2;               \
    *(bf16x8*)(K_lds + (b) * SHM_K + kswz<DQK>(sr, kc_)) = sr_[i].ks0;                       \
    *(bf16x8*)(K_lds + (b) * SHM_K + kswz<DQK>(32 + sr, kc_)) = sr_[i].ks1;                  \
    if constexpr (DQK == 192) *(bf16x8*)(K_lds + (b) * SHM_K + kswz<DQK>(krr, (128 + krc) * 2)) = sr_[i].ks2; } while (0)
#define ATT_SWAIT() do { if constexpr (SDEPTH == 2) { if constexpr (DQK == 192) asm volatile("s_waitcnt vmcnt(5)" ::: "memory"); else asm volatile("s_waitcnt vmcnt(4)" ::: "memory"); } \
    else asm volatile("s_waitcnt vmcnt(0)" ::: "memory"); } while (0)
#define ATT_RESC(a) do { if (__any((a) < 1.f)) { if (hi == 0) al_l[r32] = (a); asm volatile("s_waitcnt lgkmcnt(0)" ::: "memory"); \
    _Pragma("unroll") for (int d = 0; d < 4; ++d) _Pragma("unroll") for (int r = 0; r < 16; ++r) o[d][r] *= al_l[crow(r, hi)]; } } while (0)
  f32x16 pA0, pA1, pB0, pB1; float mnA, mnB, alA, alB; bf16x8 pa0, pa1, pa2, pa3; const int NT = seq / KVBLK;
  if (wid >= 4) __builtin_amdgcn_s_setprio(1);
  constexpr int SE = 0, SO = SDEPTH - 1;
  ATT_SLOAD(SE, 0); if constexpr (SDEPTH == 2) ATT_SLOAD(SO, KVBLK);
  if constexpr (DQK == 128) { if (qnw != nullptr) {
    float ss = 0.f;
#pragma unroll
    for (int d0 = 0; d0 < 8; ++d0)
#pragma unroll
      for (int e = 0; e < 8; ++e) { const float v = __uint_as_float((unsigned)(unsigned short)qr[d0][e] << 16); ss += v * v; }
    ss += __shfl_xor(ss, 32);
    const float rstd = 1.0f / sqrtf(ss * (1.f / 128.f) + 1e-6f);
    const bool dr = pos0 >= 0;
#pragma unroll
    for (int blk = 0; blk < 2; ++blk)
#pragma unroll
      for (int par = 0; par < 2; ++par) { const int dl = blk * 4 + par, dh = dl + 2;
        const int pos = (dr ? pos0 : 0) + wid * QBLK + r32; const float* tp = ropeB + (((blk == 0 ? pos >> 6 : pos & 63) * 32 + par * 16 + hi * 8) * 2);
        f32x4_t qtp[4], qwl[2], qwh[2];
#pragma unroll
        for (int i = 0; i < 4; ++i) qtp[i] = *(const f32x4_t*)(tp + 4 * i);
        qwl[0] = *(const f32x4_t*)(qnw + dl * 16 + hi * 8); qwl[1] = *(const f32x4_t*)(qnw + dl * 16 + hi * 8 + 4); qwh[0] = *(const f32x4_t*)(qnw + dh * 16 + hi * 8); qwh[1] = *(const f32x4_t*)(qnw + dh * 16 + hi * 8 + 4);
        u32x4 nl, nh;
#pragma unroll
        for (int e2 = 0; e2 < 4; ++e2) { float yl[2], yh[2];
#pragma unroll
          for (int h2 = 0; h2 < 2; ++h2) { const int e = 2 * e2 + h2;
            const float xl = __uint_as_float((unsigned)(unsigned short)qr[dl][e] << 16) * rstd * qwl[e >> 2][e & 3], xh = __uint_as_float((unsigned)(unsigned short)qr[dh][e] << 16) * rstd * qwh[e >> 2][e & 3];
            const float c = dr ? qtp[e >> 1][(e & 1) * 2] : 1.f, s = dr ? qtp[e >> 1][(e & 1) * 2 + 1] : 0.f;
            yl[h2] = xl * c - xh * s; yh[h2] = xh * c + xl * s; }
          nl[e2] = cvtpk(yl[0], yl[1]); nh[e2] = cvtpk(yh[0], yh[1]); }
        qr[dl] = *reinterpret_cast<bf16x8*>(&nl); qr[dh] = *reinterpret_cast<bf16x8*>(&nh); }
  } }
  if constexpr (DQK == 192) {
    if (pos0 >= 0) {
      bf16x8 qa = qr[8], qb = qr[9], qc = qr[10], qd = qr[11]; u32x4 na, nb, nc, nd;
#pragma unroll
      for (int e2 = 0; e2 < 4; ++e2) {
        float o[4][2];
#pragma unroll
        for (int h2 = 0; h2 < 2; ++h2) { const int e = 2 * e2 + h2;
          const float va = __uint_as_float((unsigned)(unsigned short)qa[e] << 16), vb = __uint_as_float((unsigned)(unsigned short)qb[e] << 16);
          const float vc = __uint_as_float((unsigned)(unsigned short)qc[e] << 16), vd = __uint_as_float((unsigned)(unsigned short)qd[e] << 16);
          const float cR = cr[e >> 1][(e & 1) * 2], sR = cr[e >> 1][(e & 1) * 2 + 1], cC = cc[e >> 1][(e & 1) * 2], sC = cc[e >> 1][(e & 1) * 2 + 1];
          o[0][h2] = va * cR - vb * sR; o[1][h2] = vb * cR + va * sR; o[2][h2] = vc * cC - vd * sC; o[3][h2] = vd * cC + vc * sC; }
        na[e2] = cvtpk(o[0][0], o[0][1]); nb[e2] = cvtpk(o[1][0], o[1][1]); nc[e2] = cvtpk(o[2][0], o[2][1]); nd[e2] = cvtpk(o[3][0], o[3][1]);
      }
      qr[8] = *reinterpret_cast<bf16x8*>(&na); qr[9] = *reinterpret_cast<bf16x8*>(&nb); qr[10] = *reinterpret_cast<bf16x8*>(&nc); qr[11] = *reinterpret_cast<bf16x8*>(&nd);
    }
  }
  if constexpr (SDEPTH == 2) { if constexpr (DQK == 192) asm volatile("s_waitcnt vmcnt(5)" ::: "memory"); else asm volatile("s_waitcnt vmcnt(4)" ::: "memory"); } else asm volatile("s_waitcnt vmcnt(0)" ::: "memory");
  ATT_SWRITE(0, SE); __syncthreads();
  qkt<DQK>(pA0, pA1, K_lds, qr, r32, hi); partialSM(pA0, pA1, m_reg, mnA, alA, C, thr_raw);
  if constexpr (SDEPTH == 2) { if (2 < NT) ATT_SLOAD(SE, 2 * KVBLK); } else ATT_SLOAD(SO, KVBLK);
  ATT_SWAIT(); ATT_SWRITE(1, SO); __syncthreads();
  for (int j = 1; j + 1 < NT; j += 2) {
    ATT_SBAR(); qkt<DQK>(pB0, pB1, K_lds + SHM_K, qr, r32, hi);
    finishSM(pA0, pA1, alA, l_reg, pa0, pa1, pa2, pa3); ATT_SBAR();
    ATT_SLOAD(SO, (j + SDEPTH) * KVBLK); ATT_SBAR();
    pv_d0(o, vb0, pa0, pa1, pa2, pa3); partialSM(pB0, pB1, m_reg, mnB, alB, C, thr_raw);
    __syncthreads(); ATT_SWAIT(); ATT_SWRITE(0, SE);
    ATT_RESC(alB); __syncthreads();
    ATT_SBAR(); qkt<DQK>(pA0, pA1, K_lds, qr, r32, hi);
    finishSM(pB0, pB1, alB, l_reg, pa0, pa1, pa2, pa3); ATT_SBAR();
    if (SDEPTH == 1 || j + 3 < NT) ATT_SLOAD(SE, (j + 1 + SDEPTH) * KVBLK); ATT_SBAR();
    pv_d0(o, vb0 + SHM_V, pa0, pa1, pa2, pa3); partialSM(pA0, pA1, m_reg, mnA, alA, C, thr_raw);
    __syncthreads(); ATT_SWAIT(); ATT_SWRITE(1, SO);
    ATT_RESC(alA); __syncthreads();
  }
  ATT_SBAR(); qkt<DQK>(pB0, pB1, K_lds + SHM_K, qr, r32, hi);
  finishSM(pA0, pA1, alA, l_reg, pa0, pa1, pa2, pa3); ATT_SBAR();
  pv_d0(o, vb0, pa0, pa1, pa2, pa3); partialSM(pB0, pB1, m_reg, mnB, alB, C, thr_raw);
  __syncthreads(); ATT_RESC(alB);
  finishSM(pB0, pB1, alB, l_reg, pa0, pa1, pa2, pa3); ATT_SBAR();
  pv_d0(o, vb0 + SHM_V, pa0, pa1, pa2, pa3);
  if (hi == 0) li_l[r32] = l_reg; asm volatile("s_waitcnt lgkmcnt(0)" ::: "memory");
  float rli[16];
#pragma unroll
  for (int r = 0; r < 16; ++r) rli[r] = __builtin_amdgcn_rcpf(li_l[crow(r, hi)]);
  bf16_t* Ow = Ob + (long)(wid * QBLK) * LDO; const unsigned offO = (unsigned)(4 * hi * LDO + r32);
#pragma unroll
  for (int r = 0; r < 16; ++r) { bf16_t* Or = Ow + ((r & 3) + 8 * (r >> 2)) * LDO;
#pragma unroll
    for (int d0 = 0; d0 < 4; ++d0) Or[offO + d0 * 32] = (bf16_t)(cvtpk(o[d0][r] * rli[r], 0.f) & 0xffffu); }
  __builtin_amdgcn_s_setprio(0);
  __syncthreads();
#undef ATT_SLOAD
#undef ATT_SWRITE
#undef ATT_SWAIT
#undef ATT_RESC
}
#undef ATT_SBAR
}

constexpr int NWAVES = 8;
#ifndef MK_ONE_LAUNCH
#define MK_ONE_LAUNCH 1
#endif
constexpr int DM = 2048, NB = 8, SEQ = 4096, CTXL = 256, TPB = SEQ + CTXL  ;
constexpr int MR = NB * TPB  , NTM = MR / 256  ;
constexpr int DFF = 5632, NUP = 2 * DFF, NPROJ = 2368, NPROJP = 2560, NSC = 6144;
constexpr int NQB = 1536, NKVB = 2048;
constexpr float EPS = 1e-6f;
constexpr int MODW = 6 * DM;
constexpr int NPH = 36;

constexpr size_t MiB = 1u << 20;
constexpr size_t WS_CTL = 0, CTL_ZERO_BYTES = 1 * MiB;
constexpr int CW_BAR = 4096;
constexpr size_t WS_MOD = 1 * MiB;
constexpr size_t WS_TAB = 3 * MiB;
constexpr size_t WS_WEFF = 3 * MiB + 65536;
constexpr size_t WS_SHIFT = 4 * MiB;
constexpr size_t WS_SS = 5 * MiB;
constexpr size_t WS_SB = 7 * MiB;
constexpr size_t WS_W = 25 * MiB;
constexpr size_t W_IN_SZ = (size_t)NPROJP * DM * 2, W_UQ_SZ = (size_t)NQB * 512 * 2, W_UKV_SZ = (size_t)NKVB * 256 * 2, W_O_SZ = (size_t)DM * DM * 2,
                 W_SCIN_SZ = (size_t)NSC * DM * 2, W_SCOUT_SZ = (size_t)DM * DM * 2, W_UP_SZ = (size_t)NUP * DM * 2, W_DN_SZ = (size_t)DM * DFF * 2;
constexpr size_t WS_W_IN = WS_W, WS_W_SCIN = WS_W_IN + 2 * W_IN_SZ, WS_W_UP = WS_W_SCIN + 2 * W_SCIN_SZ, WS_W_UQ = WS_W_UP + 4 * W_UP_SZ, WS_W_UKV = WS_W_UQ + 2 * W_UQ_SZ,
                 WS_W_O = WS_W_UKV + 2 * W_UKV_SZ, WS_W_SCOUT = WS_W_O + 2 * W_O_SZ, WS_W_DN = WS_W_SCOUT + 2 * W_SCOUT_SZ, WS_W_END = WS_W_DN + 4 * W_DN_SZ;
constexpr int SB_COL_IN = 0, SB_COL_SCIN = 2 * NPROJP, SB_COL_UP = 2 * NPROJP + 2 * NSC;
static_assert(WS_W_END == 394 * MiB && WS_W_UQ - WS_W == (size_t)pg8::SB_LD * DM * 2 && SB_COL_UP + 4 * NUP == pg8::SB_LD, "weight copies end at 394 MiB; SB GEMM view");
static_assert(WS_WEFF + 4 * 2 * 9 * DM * 4 <= WS_SHIFT && WS_SS + (size_t)MR * 8 * 4 <= WS_SB && WS_SB + (size_t)72 * pg8::SB_LD * 4 <= WS_W, "low d_ws map");
constexpr size_t WS_X = 394 * MiB;
constexpr size_t WS_H = WS_X + (size_t)MR * DM * 2;
constexpr size_t WS_O = WS_H + (size_t)MR * DM * 2;
constexpr size_t WS_S = WS_O + (size_t)MR * DM * 2;
static_assert(WS_S == 802 * MiB, "scratch starts at 802 MiB");
constexpr size_t WS_PROJ = WS_S, WS_QA = WS_PROJ + (size_t)MR * NPROJP * 2, WS_KA = WS_QA + (size_t)MR * 1024 * 2, WS_CQ = WS_KA + (size_t)MR * 256 * 2,
                 WS_CKV = WS_CQ + (size_t)MR * 512 * 2, WS_KR = WS_CKV + (size_t)MR * 256 * 2, WS_QB = WS_KR + 5 * MiB, WS_KVB = WS_QB + (size_t)MR * NQB * 2,
                 WS_ATT_END = WS_KVB + (size_t)MR * NKVB * 2;
constexpr size_t WS_SCP = WS_S;
constexpr size_t WS_BB = WS_S, WS_SCHALO = WS_BB + (size_t)MR * DM * 2;
constexpr size_t WS_ACT = WS_S, WS_HALO = WS_ACT + (size_t)MR * DFF * 2, WS_FFN_END = WS_HALO + (size_t)NTM * 4 * 2 * DFF * 4;
constexpr size_t WS_PART = WS_S;
constexpr size_t WS_END = 1536 * MiB;
constexpr size_t WS_SLAB = WS_END - 64 * MiB;
static_assert(WS_ATT_END <= WS_SLAB && WS_SCP + (size_t)MR * NSC * 2 <= WS_SLAB && WS_FFN_END <= WS_SLAB && WS_SCP + (size_t)MR * NSC * 2 <= WS_END && WS_FFN_END <= WS_END && WS_PART + (size_t)16 * 4 * 9 * MODW * 4 <= WS_END, "d_ws map");

constexpr int RING_OFF = 0, RING_BYTES = 131072;
constexpr int XTRA_OFF = RING_BYTES, XTRA_BYTES = 24576;
constexpr int LDSCTL_OFF = XTRA_OFF + XTRA_BYTES, MISC_OFF = LDSCTL_OFF + 320;
constexpr int LDS_BYTES = LDSCTL_OFF + 1024;
static_assert(MISC_OFF + 128 <= LDS_BYTES && LDS_BYTES <= 163840, "LDS map");

#define GAS __attribute__((address_space(1)))
#define LAS __attribute__((address_space(3)))
typedef unsigned short bf16;
typedef unsigned v4u __attribute__((ext_vector_type(4)));
typedef unsigned v2u __attribute__((ext_vector_type(2)));
typedef float f32x4 __attribute__((ext_vector_type(4)));
typedef GAS unsigned gu32;
#define RLX_AGENT __ATOMIC_RELAXED, __HIP_MEMORY_SCOPE_AGENT
#define LDS_WAIT() asm volatile("s_waitcnt lgkmcnt(0)" ::: "memory")
#define VM_WAIT() asm volatile("s_waitcnt vmcnt(0)" ::: "memory")
__device__ __forceinline__ unsigned pk2(float lo, float hi) { return pg8::cvt_pk_bf16(lo, hi); }
__device__ __forceinline__ float bflo(unsigned w) { return __uint_as_float(w << 16); }
__device__ __forceinline__ float bfhi(unsigned w) { return __uint_as_float(w & 0xffff0000u); }
__device__ __forceinline__ float bf1(bf16 h) { return __uint_as_float((unsigned)h << 16); }
#define XB_TMO      128
#define XB_XCNT(j)  (256  + 64 * (j))
#define XB_XSUB(j)  (1280 + 64 * (j))
#define XB_XGEN(j)  (2304 + 64 * (j))
#define XB_TOP      3328
#define XB_TOPGEN   3392
#define XCD_BAR_WORDS 3456
#define XB_SPIN_CAP (1u << 18)
#define LAS_GLOBAL __attribute__((address_space(1)))

__device__ __forceinline__ unsigned xb_ld(unsigned* p)              { return __hip_atomic_load((LAS_GLOBAL unsigned*)p, __ATOMIC_RELAXED, __HIP_MEMORY_SCOPE_AGENT); }
__device__ __forceinline__ unsigned xb_add(unsigned* p, unsigned v) { return __hip_atomic_fetch_add((LAS_GLOBAL unsigned*)p, v, __ATOMIC_RELAXED, __HIP_MEMORY_SCOPE_AGENT); }
__device__ __forceinline__ unsigned xb_xcc_id() { return (unsigned)__builtin_amdgcn_s_getreg((3 << 11) | 20) & 0xFu; }
#define XB_SPIN(cond, bar) do { unsigned _sp = 0; while (cond) { __builtin_amdgcn_s_sleep(1); \
    if ((++_sp & 255u) == 0u) { if (xb_ld(&(bar)[XB_TMO])) break; if (_sp > XB_SPIN_CAP) { xb_add(&(bar)[XB_TMO], 1u); break; } } } } while (0)

struct XcdBarrier {
    unsigned* bar; unsigned x;
    volatile LAS unsigned* st;
};

__device__ __forceinline__ XcdBarrier xcd_barrier_post(unsigned* bar, volatile LAS unsigned* st) {
    XcdBarrier b; b.bar = bar; b.x = xb_xcc_id(); b.st = st;
    if (threadIdx.x == 0) (void)xb_add(&bar[XB_XCNT(b.x)], 1u);
    return b;
}
__device__ __forceinline__ void xcd_barrier_complete(unsigned* bar, unsigned x, unsigned& nloc, unsigned& nx) {
    const unsigned G = gridDim.x * gridDim.y * gridDim.z;
    unsigned sum, cnt, mine, sp = 0u;
    for (;;) {
        sum = 0u; cnt = 0u; mine = 0u;
#pragma unroll
        for (unsigned j = 0; j < 16; ++j) { const unsigned c = xb_ld(&bar[XB_XCNT(j)]); sum += c; cnt += (c > 0u) ? 1u : 0u; mine = (j == x) ? c : mine; }
        if (sum == G) break;
        __builtin_amdgcn_s_sleep(1);
        if ((++sp & 255u) == 0u) { if (xb_ld(&bar[XB_TMO])) break; if (sp > XB_SPIN_CAP) { xb_add(&bar[XB_TMO], 1u); break; } }
    }
    nloc = mine > 0u ? mine : 1u; nx = cnt > 0u ? cnt : 1u;
}

__device__ __forceinline__ void xcd_barrier(const XcdBarrier& b, const bool t0  ) {
    asm volatile("s_waitcnt vmcnt(0)" ::: "memory");
    __syncthreads();
    if (t0) {
        unsigned* bar = b.bar;
        __builtin_amdgcn_s_waitcnt(0);
        unsigned nloc = b.st[0], nx = b.st[1];
        if (nloc == 0u) { xcd_barrier_complete(bar, b.x, nloc, nx); b.st[0] = nloc; b.st[1] = nx; }
        const unsigned old = xb_add(&bar[XB_XSUB(b.x)], 1u);
        const unsigned gen = old / nloc;
        if (old + 1u == (gen + 1u) * nloc) {
            __builtin_amdgcn_fence(__ATOMIC_RELEASE, "agent");
            asm volatile("s_waitcnt vmcnt(0)" ::: "memory");
            const unsigned og = xb_add(&bar[XB_TOP], 1u);
            const unsigned tg = og / nx;
            if (og + 1u == (tg + 1u) * nx) xb_add(&bar[XB_TOPGEN], 1u);
            else XB_SPIN(xb_ld(&bar[XB_TOPGEN]) == tg, bar);
            __builtin_amdgcn_fence(__ATOMIC_ACQUIRE, "agent");
            xb_add(&bar[XB_XGEN(b.x)], 1u);
            asm volatile("s_waitcnt vmcnt(0)" ::: "memory");
        } else {
            XB_SPIN(xb_ld(&bar[XB_XGEN(b.x)]) == gen, bar);
            __builtin_amdgcn_fence(__ATOMIC_ACQUIRE, "agent");
            asm volatile("s_waitcnt vmcnt(0)" ::: "memory");
        }
    }
    __syncthreads();
}

__device__ __forceinline__ float wave_sum(float v) {
#pragma unroll
    for (int o = 1; o < 64; o <<= 1) v += __shfl_xor(v, o);
    return v;
}
__device__ __forceinline__ void p0_transpose_item(const float* W, int K, int N, bf16* WT, LAS float* scr, int item, int lane, int permmode) {
    const int nblk = N / 64, kb = item / nblk, nb = item % nblk, k0 = 64 * kb, n0 = 64 * nb;
    int d0 = n0; if (permmode == 1) { const int gu = n0 >= DFF ? 1 : 0, j = n0 - gu * DFF; d0 = (j >> 7) * 256 + gu * 128 + (j & 127); }
    if (permmode == 2) { const int seg = n0 >> 11, j = n0 & 2047, q = j >> 8, r = j & 255; d0 = seg == 0 ? 768 * q + r : 768 * q + 256 + (r >> 7) * 256 + (seg == 2 ? 128 : 0) + (r & 127); }
    const int kr = lane >> 4, nc = (lane & 15) * 4;
    const GAS f32x4* src = (const GAS f32x4*)(W + (size_t)(k0 + kr) * N + n0 + nc);
    f32x4 v[16];
#pragma unroll
    for (int i = 0; i < 16; ++i) v[i] = __builtin_nontemporal_load(src + (size_t)i * N);
#pragma unroll
    for (int i = 0; i < 16; ++i) { LAS float* d = scr + (4 * i + kr) * 65 + nc; d[0] = v[i].x; d[1] = v[i].y; d[2] = v[i].z; d[3] = v[i].w; }
    LDS_WAIT(); asm volatile("" ::: "memory");
    const int c = lane & 7;
#pragma unroll
    for (int j = 0; j < 8; ++j) { const int n = (lane >> 3) + 8 * j; const LAS float* s = scr + (8 * c) * 65 + n;
        v4u o; o.x = pk2(s[0 * 65], s[1 * 65]); o.y = pk2(s[2 * 65], s[3 * 65]); o.z = pk2(s[4 * 65], s[5 * 65]); o.w = pk2(s[6 * 65], s[7 * 65]);
        *(GAS v4u*)(WT + (size_t)(d0 + n) * K + k0 + 8 * c) = o; }
    LDS_WAIT(); asm volatile("" ::: "memory");
}
__device__ __forceinline__ void sincos_d(double a, double& s, double& c) {
    const double TWO_PI = 6.283185307179586476925286766559;
    const double k = __builtin_rint(a * (1.0 / TWO_PI)); const double r = a - k * TWO_PI, r2 = r * r;
    double ts = r, tc = 1.0; s = r; c = 1.0;
#pragma unroll
    for (int n = 1; n <= 16; ++n) { tc = -tc * r2 / (double)((2 * n - 1) * (2 * n)); ts = -ts * r2 / (double)((2 * n) * (2 * n + 1)); c += tc; s += ts; }
}

struct Args { const float* in[23]; float* out; unsigned char* ws; int ph_lo, ph_hi; };
typedef const Args __attribute__((address_space(4)))* KAp;
__device__ __forceinline__ KAp kargs() { KAp p = (KAp)__builtin_amdgcn_kernarg_segment_ptr(); asm volatile("" : "+s"(p)); return p; }
struct TI { int tid, lane, wave, G, bx, vcu, gw, NGW; };
__device__ __forceinline__ TI thread_info(const int wv) {
    TI t; int tid = wv * 64 + pg8::lane_id_l(); asm volatile("" : "+v"(tid)); int bx = blockIdx.x; asm volatile("" : "+s"(bx)); int G = gridDim.x; asm volatile("" : "+s"(G));
    t.tid = tid; t.lane = tid & 63; t.wave = __builtin_amdgcn_readfirstlane(tid >> 6); t.G = G; t.bx = bx;
    t.vcu = (G % 8 == 0) ? (bx % 8) * (G / 8) + bx / 8 : bx; t.gw = t.vcu * NWAVES + t.wave; t.NGW = G * NWAVES; return t;
}
#define A_X(ka)        ((ka)->in[0])
#define A_C(ka)        ((ka)->in[1])
#define A_CTX(ka)      ((ka)->in[2])
#define A_CCTX(ka)     ((ka)->in[3])
#define A_WADA(ka)     ((ka)->in[4])
#define A_BADA(ka)     ((ka)->in[5])
#define A_NMIX(ka)     ((ka)->in[6])
#define A_NFFN(ka)     ((ka)->in[7])
#define A_WIN(ka)      ((ka)->in[8])
#define A_QNORM(ka)    ((ka)->in[9])
#define A_KNORM(ka)    ((ka)->in[10])
#define A_MQNORM(ka)   ((ka)->in[11])
#define A_MKVNORM(ka)  ((ka)->in[12])
#define A_WUQ(ka)      ((ka)->in[13])
#define A_WUKV(ka)     ((ka)->in[14])
#define A_WO(ka)       ((ka)->in[15])
#define A_SCWIN(ka)    ((ka)->in[16])
#define A_SCCONV(ka)   ((ka)->in[17])
#define A_SCWOUT(ka)   ((ka)->in[18])
#define A_FUP(ka)      ((ka)->in[19])
#define A_FCONV(ka)    ((ka)->in[20])
#define A_FDOWN(ka)    ((ka)->in[21])
#define A_FNORM(ka)    ((ka)->in[22])

constexpr int I_IN = 32 * 37, I_UQ = 8 * 24, I_UKV = 4 * 32, I_O = 32 * 32, I_SCIN = 32 * 96, I_SCOUT = 32 * 32, I_UP = 32 * 176, I_DN = 88 * 32;
constexpr int N_TR_EARLY = 2 * (I_IN + I_SCIN) + I_UQ + I_UKV + I_O + 4 * I_UP, N_TR_LATE = I_UQ + I_UKV + I_O + 2 * I_SCOUT + 2 * I_DN;
template <bool LATE>
__device__ __forceinline__ void tr_item(KAp ka, unsigned char* ws, LAS float* scr, int r, int lane) {
    const float* src = nullptr; bf16* dst = nullptr; int K = 0, N = 0; bool found = false; int permmode = 0;
#define SEL(SRC, KK, NN, CNT, DST) if (!found) { if (r < (CNT)) { src = (SRC); K = (KK); N = (NN); dst = (bf16*)(DST); found = true; } else r -= (CNT); }
#pragma unroll
    for (int i = 0; i < 2; ++i) {
        if (!LATE) { SEL(A_WIN(ka) + (size_t)i * DM * NPROJ, DM, NPROJ, I_IN, ws + WS_W_IN + i * W_IN_SZ) }
        if (LATE == (i == 1)) {
            SEL(A_WUQ(ka) + (size_t)i * 512 * NQB, 512, NQB, I_UQ, ws + WS_W_UQ + i * W_UQ_SZ)
            SEL(A_WUKV(ka) + (size_t)i * 256 * NKVB, 256, NKVB, I_UKV, ws + WS_W_UKV + i * W_UKV_SZ)
            SEL(A_WO(ka) + (size_t)i * DM * DM, DM, DM, I_O, ws + WS_W_O + i * W_O_SZ) }
        if (!LATE) { SEL(A_SCWIN(ka) + (size_t)i * DM * NSC, DM, NSC, I_SCIN, ws + WS_W_SCIN + i * W_SCIN_SZ) if (found && N == NSC) permmode = 2; }
        if (LATE) { SEL(A_SCWOUT(ka) + (size_t)i * DM * DM, DM, DM, I_SCOUT, ws + WS_W_SCOUT + i * W_SCOUT_SZ) }
    }
#pragma unroll
    for (int i = 0; i < 4; ++i) {
        if (!LATE) { SEL(A_FUP(ka) + (size_t)i * DM * NUP, DM, NUP, I_UP, ws + WS_W_UP + i * W_UP_SZ) if (found && N == NUP) permmode = 1; }
        if (LATE && i >= 2) { SEL(A_FDOWN(ka) + (size_t)i * DFF * DM, DFF, DM, I_DN, ws + WS_W_DN + i * W_DN_SZ) }
    }
#undef SEL
    if (found) p0_transpose_item(src, K, N, dst, scr, r, lane, permmode);
}
__device__ __forceinline__ void ph_dn0_tr(KAp ka, LAS unsigned char* lds, const int wv, int idx, int cnt, int layer  ) {
    const TI t = thread_info(wv);
    LAS float* scr = (LAS float*)(lds + RING_OFF + t.wave * 16640);
    for (int it = idx * NWAVES + t.wave; it < I_DN; it += cnt * NWAVES) p0_transpose_item(A_FDOWN(ka) + (size_t)layer * DFF * DM, DFF, DM, (bf16*)(ka->ws + WS_W_DN + layer * W_DN_SZ), scr, it, t.lane, 0);
}
__device__ __forceinline__ void ph_late_tr(KAp ka, LAS unsigned char* lds, const int wv, int idx, int cnt) {
    const TI t = thread_info(wv);
    LAS float* scr = (LAS float*)(lds + RING_OFF + t.wave * 16640);
    for (int it = idx * NWAVES + t.wave; it < N_TR_LATE; it += cnt * NWAVES) tr_item<true>(ka, ka->ws, scr, it, t.lane);
}
__device__ __forceinline__ void ph_prologue(KAp ka, LAS unsigned char* lds, const int wv) {
    const TI t = thread_info(wv); const int gw = t.gw, NGW = t.NGW, wave = t.wave, lane = t.lane, vcu = t.vcu;
    LAS float* scr = (LAS float*)(lds + RING_OFF + wave * 16640);
    unsigned char* ws = (ka)->ws;
    constexpr int N_ADA = 4 * 48 * 16;
    for (int it = gw; it < N_ADA; it += NGW) {
        {
            const int kc = it & 15, cc = (it >> 4) % 48, l = it / 768, n0 = cc * 256 + lane * 4;
            f32x4 acc[9];
#pragma unroll
            for (int b = 0; b < 9; ++b) acc[b] = (f32x4){0.f, 0.f, 0.f, 0.f};
            const float* wp = A_WADA(ka) + ((size_t)l * DM + kc * 128) * MODW + n0;
            for (int half = 0; half < 2; ++half) {
                const int kb = kc * 128 + half * 64;
                float sv[9];
#pragma unroll
                for (int b = 0; b < 9; ++b) { const float xv = (b < 8) ? A_C(ka)[b * DM + kb + lane] : A_CCTX(ka)[kb + lane]; sv[b] = xv / (1.f + __expf(-xv)); }
#pragma unroll 16
                for (int kk = 0; kk < 64; ++kk) {
                    const f32x4 w = __builtin_nontemporal_load((const f32x4*)(wp + (size_t)(half * 64 + kk) * MODW));
#pragma unroll
                    for (int b = 0; b < 9; ++b) { const float s = __int_as_float(__builtin_amdgcn_readlane(__float_as_int(sv[b]), kk)); acc[b] += s * w; }
                }
            }
            float* part = (float*)(ws + WS_PART) + ((size_t)(kc * 4 + l) * 9) * MODW + n0;
#pragma unroll
            for (int b = 0; b < 9; ++b) *(f32x4*)(part + (size_t)b * MODW) = acc[b];
        }
    }
    {   const int amin = N_ADA / NGW, H = N_ADA - amin * NGW, Lc = NGW - H;
        const int PL = (H > 0) ? (Lc * 5 < N_TR_EARLY ? Lc * 5 : N_TR_EARLY) : 0;
        const int nL = (gw >= H && gw - H < PL) ? (PL - (gw - H) + Lc - 1) / Lc : 0;
        for (int j = 0; ; ++j) { const int it = j < nL ? (gw - H) + j * Lc : PL + gw + (j - nL) * NGW; if (it >= N_TR_EARLY) break; tr_item<false>(ka, ws, scr, it, lane); } }
    if (vcu == 0) {
        float* tabA = (float*)(ws + WS_TAB); float* tabB = (float*)(ws + WS_TAB + 16384);
        for (int e = wave * 64 + lane; e < 64 * 48; e += NWAVES * 64) {
            const int p = e / 48, q = e % 48; const bool isA = q < 32; const int i = isA ? q : q - 32;
            const float inv = (float)exp2(-(double)i / (isA ? 32.0 : 16.0) * 13.287712379549449);
            const float ang = (float)p * inv; double s, c; sincos_d((double)ang, s, c);
            float* t = isA ? tabA + (p * 32 + i) * 2 : tabB + (p * 16 + i) * 2; t[0] = (float)c; t[1] = (float)s;
        }
    }
}
__device__ __forceinline__ void ph_modfin(KAp ka, const int wv) {
    const TI t = thread_info(wv); const int gtid = t.gw * 64 + t.lane, NGT = t.NGW * 64;
    const float* part = (const float*)((ka)->ws + WS_PART); float* mod = (float*)((ka)->ws + WS_MOD);
    bf16* SHIFT = (bf16*)((ka)->ws + WS_SHIFT); float* WEFF = (float*)((ka)->ws + WS_WEFF);
    for (int e = gtid; e < 4 * 9 * MODW / 4; e += NGT) {
        const int n4 = e % (MODW / 4), lb = e / (MODW / 4), l = lb / 9, bb = lb - l * 9;
        f32x4 a = *(const f32x4*)(A_BADA(ka) + (size_t)l * MODW + n4 * 4);
#pragma unroll
        for (int kc = 0; kc < 16; ++kc) a += *(const f32x4*)(part + ((size_t)(kc * 4 + l) * 9 + bb) * MODW + n4 * 4);
        *(f32x4*)(mod + (size_t)lb * MODW + n4 * 4) = a;
        const int seg = (n4 * 4) / DM, col = (n4 * 4) % DM;
        if (seg == 0 || seg == 3) { v2u w; w.x = pk2(a[0], a[1]); w.y = pk2(a[2], a[3]); *(v2u*)(SHIFT + ((size_t)((l * 2 + (seg == 3)) * 9 + bb)) * DM + col) = w; }
        if (seg == 1 || seg == 4) { const f32x4 nw = *(const f32x4*)((seg == 4 ? A_NFFN(ka) : A_NMIX(ka)) + (size_t)l * DM + col);
            *(f32x4*)(WEFF + ((size_t)((l * 2 + (seg == 4)) * 9 + bb)) * DM + col) = nw * (a + 1.0f); }
    }
}
__device__ __forceinline__ void ph_xinit(KAp ka, const int wv, const int nsb  ) {
    const TI t = thread_info(wv); const int gw = t.gw, NGW = t.NGW, lane = t.lane;
    bf16* X = (bf16*)(ka->ws + WS_X); bf16* H = (bf16*)(ka->ws + WS_H); float* SS = (float*)(ka->ws + WS_SS); const float* WEFF = (const float*)(ka->ws + WS_WEFF);
    constexpr int XI_EXTRA = 8;
    const int nfree = t.G - nsb, LA = nfree * NWAVES, RA = (nsb > 0 && nfree > 0) ? LA * XI_EXTRA : 0;
    const int rankA = (t.bx - nsb) * NWAVES + t.wave, nA = (t.bx >= nsb && RA > 0) ? XI_EXTRA : 0;
#define XI_ROW(j) ((j) < nA ? rankA + (j) * LA : RA + gw + ((j) - nA) * NGW)
    for (int jj = 0; XI_ROW(jj) < MR; jj += 2) {
        const int r0 = XI_ROW(jj), r1_ = XI_ROW(jj + 1);
        f32x4 v[2][8]; bool val[2]; int bidx[2];
#pragma unroll
        for (int q = 0; q < 2; ++q) { const int r = q ? r1_ : r0; val[q] = r < MR; const int ru = val[q] ? r : r0;
            const int b = ru / TPB, tt = ru % TPB; bidx[q] = (tt < CTXL) ? 8 : b;
            const float* srow = (tt < CTXL) ? A_CTX(ka) + ((size_t)b * CTXL + tt) * DM : A_X(ka) + ((size_t)b * SEQ + (tt - CTXL)) * DM;
            const GAS f32x4* s4 = (const GAS f32x4*)srow + lane;
#pragma unroll
            for (int j = 0; j < 8; ++j) v[q][j] = s4[64 * j]; }
#pragma unroll
        for (int q = 0; q < 2; ++q) { if (!val[q]) continue;
            const int r = q ? r1_ : r0;
            GAS v2u* d8 = (GAS v2u*)(X + (size_t)r * DM) + lane; GAS v2u* o8 = (GAS v2u*)(H + (size_t)r * DM) + lane;
            const float* wf = WEFF + (size_t)bidx[q] * DM;
            float ss = 0.f;
#pragma unroll
            for (int j = 0; j < 8; ++j) { const f32x4 x = v[q][j]; v2u xo; xo.x = pk2(x.x, x.y); xo.y = pk2(x.z, x.w); d8[64 * j] = xo; ss += (x.x * x.x + x.y * x.y) + (x.z * x.z + x.w * x.w);
                const f32x4 y = x * *(const f32x4*)(wf + 4 * lane + 256 * j); v2u o; o.x = pk2(y.x, y.y); o.y = pk2(y.z, y.w); o8[64 * j] = o; }
            ss = wave_sum(ss);
            if (lane == 0) { float z_ = 0.f; asm volatile("" : "+v"(z_));
                *(f32x4*)(SS + (size_t)r * 8) = (f32x4){ss, z_, z_, z_}; *(f32x4*)(SS + (size_t)r * 8 + 4) = (f32x4){z_, z_, z_, z_}; } }
    }
}
__device__ __forceinline__ void ph_ctx_combine(KAp ka, const float* gate8  , const float* weff8, bool donorm, const int wv) {
    const TI t = thread_info(wv); const int gw = t.gw, NGW = t.NGW, lane = t.lane;
    bf16* X = (bf16*)(ka->ws + WS_X); bf16* H = (bf16*)(ka->ws + WS_H); float* SS = (float*)(ka->ws + WS_SS); const float* slab = (const float*)(ka->ws + WS_SLAB);
    for (int rc = gw; rc < NB * CTXL; rc += NGW) {
        const int r = (rc >> 8) * TPB + (rc & 255);
        GAS v2u* xp = (GAS v2u*)(X + (size_t)r * DM) + lane; GAS v2u* hp = (GAS v2u*)(H + (size_t)r * DM) + lane;
        float ss = 0.f;
#pragma unroll
        for (int j = 0; j < 8; ++j) { const int col = 4 * lane + 256 * j;
            f32x4 a = *(const f32x4*)(slab + (size_t)rc * DM + col);
#pragma unroll
            for (int s = 1; s < 4; ++s) a += *(const f32x4*)(slab + ((size_t)s * (NB * CTXL) + rc) * DM + col);
            const v2u xw = xp[64 * j]; f32x4 x = (f32x4){bflo(xw.x), bfhi(xw.x), bflo(xw.y), bfhi(xw.y)};
            x = x + *(const f32x4*)(gate8 + col) * a;
            v2u xo; xo.x = pk2(x.x, x.y); xo.y = pk2(x.z, x.w); xp[64 * j] = xo;
            if (donorm) { ss += (x.x * x.x + x.y * x.y) + (x.z * x.z + x.w * x.w); const f32x4 y = x * *(const f32x4*)(weff8 + col); v2u o; o.x = pk2(y.x, y.y); o.y = pk2(y.z, y.w); hp[64 * j] = o; }
        }
        if (donorm) { ss = wave_sum(ss); if (lane == 0) { float z_ = 0.f; asm volatile("" : "+v"(z_));
            *(f32x4*)(SS + (size_t)r * 8) = (f32x4){ss, z_, z_, z_}; *(f32x4*)(SS + (size_t)r * 8 + 4) = (f32x4){z_, z_, z_, z_}; } }
    }
}
__device__ __forceinline__ void ph_final(KAp ka, const int wv) {
    const TI t = thread_info(wv); const int gw = t.gw, NGW = t.NGW, lane = t.lane;
    const bf16* X = (const bf16*)((ka)->ws + WS_X);
    constexpr int NQ = 4;
    for (int rr0 = gw; rr0 < NB * SEQ; rr0 += NQ * NGW) {
        v4u w[NQ][4]; bool val[NQ];
#pragma unroll
        for (int q = 0; q < NQ; ++q) { const int rr = rr0 + q * NGW; val[q] = rr < NB * SEQ; const int ru = val[q] ? rr : rr0;
            const int r = (ru >> 12) * TPB + CTXL + (ru & 4095); const GAS v4u* xr = (const GAS v4u*)(X + (size_t)r * DM) + lane;
#pragma unroll
            for (int j = 0; j < 4; ++j) w[q][j] = xr[64 * j]; }
#pragma unroll
        for (int q = 0; q < NQ; ++q) { if (!val[q]) continue;
            f32x4 v[4][2]; float ss = 0.f;
#pragma unroll
            for (int j = 0; j < 4; ++j) { v[j][0] = (f32x4){bflo(w[q][j].x), bfhi(w[q][j].x), bflo(w[q][j].y), bfhi(w[q][j].y)}; v[j][1] = (f32x4){bflo(w[q][j].z), bfhi(w[q][j].z), bflo(w[q][j].w), bfhi(w[q][j].w)};
                ss += ((v[j][0].x * v[j][0].x + v[j][0].y * v[j][0].y) + (v[j][0].z * v[j][0].z + v[j][0].w * v[j][0].w)) + ((v[j][1].x * v[j][1].x + v[j][1].y * v[j][1].y) + (v[j][1].z * v[j][1].z + v[j][1].w * v[j][1].w)); }
            const float rstd = 1.0f / sqrtf(wave_sum(ss) * (1.f / DM) + EPS);
            GAS f32x4* o4 = (GAS f32x4*)((ka)->out + (size_t)(rr0 + q * NGW) * DM) + 2 * lane;
#pragma unroll
            for (int j = 0; j < 4; ++j) { const float* wp = A_FNORM(ka) + 8 * lane + 512 * j;
                o4[128 * j] = (v[j][0] * rstd) * *(const f32x4*)wp; o4[128 * j + 1] = (v[j][1] * rstd) * *(const f32x4*)(wp + 4); } }
    }
}
__device__ __forceinline__ void ph_attn_post(KAp ka, int i, const int wv) {
    const TI t = thread_info(wv); const int gw = t.gw, NGW = t.NGW, lane = t.lane;
    unsigned char* ws = (ka)->ws;
    const bf16* PROJ = (const bf16*)(ws + WS_PROJ); bf16* QA = (bf16*)(ws + WS_QA); bf16* KA = (bf16*)(ws + WS_KA); bf16* CQ = (bf16*)(ws + WS_CQ);
    bf16* CKV = (bf16*)(ws + WS_CKV); bf16* KR = (bf16*)(ws + WS_KR);
    const float* tabA = (const float*)(ws + WS_TAB); const float* tabB = (const float*)(ws + WS_TAB + 16384);
    const float* qn = A_QNORM(ka) + i * 128; const float* kn = A_KNORM(ka) + i * 128; const float* qnb = A_MQNORM(ka) + i * 512; const float* kvn = A_MKVNORM(ka) + i * 256;
    const float qw0 = qn[2 * lane], qw1 = qn[2 * lane + 1], kw0 = kn[2 * lane], kw1 = kn[2 * lane + 1];
    const bool odd = (lane >> 4) & 1; const float sgn = odd ? 1.f : -1.f;
    const f32x4 g0q = *(const f32x4*)(qnb + 8 * lane), g1q = *(const f32x4*)(qnb + 8 * lane + 4), gkv = *(const f32x4*)(kvn + 4 * lane);
    constexpr int NQ = 4;
    for (int r0 = gw; r0 < MR; r0 += NQ * NGW) {
        unsigned wh[NQ][10]; v4u wq[NQ]; v2u wkv[NQ]; bf16 wkr[NQ]; f32x4 csA[NQ]; float cB[NQ], sB[NQ]; bool val[NQ];
#pragma unroll
        for (int q = 0; q < NQ; ++q) {
            const int r = r0 + q * NGW; val[q] = r < MR; const int rr = val[q] ? r : r0;
            const int tt = rr % TPB; const bool isctx = tt < CTXL; const int tp = tt - CTXL, pos = (lane < 32) ? (tp >> 6) : (tp & 63);
            const bf16* pr = PROJ + (size_t)rr * NPROJP;
#pragma unroll
            for (int h = 8; h < 10; ++h) wh[q][h] = *(const unsigned*)(pr + 1024 + (h - 8) * 128 + 2 * lane);
            wq[q] = *(const v4u*)(pr + 1536 + 8 * lane); wkv[q] = *(const v2u*)(pr + 2048 + 4 * lane); wkr[q] = pr[2304 + lane];
            csA[q] = (f32x4){1.f, 0.f, 1.f, 0.f}; cB[q] = 1.f; sB[q] = 0.f;
            if (!isctx) { csA[q] = *(const f32x4*)(tabA + (pos * 32 + 2 * (lane & 15)) * 2); cB[q] = tabB[(pos * 16 + (lane & 15)) * 2]; sB[q] = tabB[(pos * 16 + (lane & 15)) * 2 + 1]; }
        }
#pragma unroll
        for (int q = 0; q < NQ; ++q) {
            if (!val[q]) continue;
            const int r = r0 + q * NGW;
#pragma unroll
            for (int h = 8; h < 10; ++h) {
                const unsigned w = wh[q][h];
                float x0 = bflo(w), x1 = bfhi(w);
                const float rstd = 1.0f / sqrtf(wave_sum(x0 * x0 + x1 * x1) * (1.f / 128.f) + EPS);
                x0 = x0 * rstd * (h < 8 ? qw0 : kw0); x1 = x1 * rstd * (h < 8 ? qw1 : kw1);
                const float p0 = __shfl_xor(x0, 16), p1 = __shfl_xor(x1, 16);
                const float y0 = x0 * csA[q].x + sgn * p0 * csA[q].y, y1 = x1 * csA[q].z + sgn * p1 * csA[q].w;
                bf16* dst = (h < 8) ? QA + (size_t)r * 1024 + h * 128 : KA + (size_t)r * 256 + (h - 8) * 128;
                *(unsigned*)(dst + 2 * lane) = pk2(y0, y1);
            }
            { const v4u w = wq[q];
              float x[8] = {bflo(w.x), bfhi(w.x), bflo(w.y), bfhi(w.y), bflo(w.z), bfhi(w.z), bflo(w.w), bfhi(w.w)}; float ss = 0.f;
#pragma unroll
              for (int e = 0; e < 8; ++e) ss += x[e] * x[e];
              const float rstd = 1.0f / sqrtf(wave_sum(ss) * (1.f / 512.f) + EPS);
              v4u o; o.x = pk2(x[0] * rstd * g0q.x, x[1] * rstd * g0q.y); o.y = pk2(x[2] * rstd * g0q.z, x[3] * rstd * g0q.w);
              o.z = pk2(x[4] * rstd * g1q.x, x[5] * rstd * g1q.y); o.w = pk2(x[6] * rstd * g1q.z, x[7] * rstd * g1q.w);
              *(v4u*)(CQ + (size_t)r * 512 + 8 * lane) = o; }
            { const v2u w = wkv[q];
              const float x0 = bflo(w.x), x1 = bfhi(w.x), x2 = bflo(w.y), x3 = bfhi(w.y);
              const float rstd = 1.0f / sqrtf(wave_sum((x0 * x0 + x1 * x1) + (x2 * x2 + x3 * x3)) * (1.f / 256.f) + EPS);
              v2u o; o.x = pk2(x0 * rstd * gkv.x, x1 * rstd * gkv.y); o.y = pk2(x2 * rstd * gkv.z, x3 * rstd * gkv.w);
              *(v2u*)(CKV + (size_t)r * 256 + 4 * lane) = o; }
            { const float xk = bf1(wkr[q]); const float pk = __shfl_xor(xk, 16);
              const float y = xk * cB[q] + sgn * pk * sB[q];
              KR[(size_t)r * 64 + lane] = (bf16)(pk2(y, 0.f) & 0xffffu); }
        }
    }
}
__device__ __forceinline__ void ph_ffn_fix(KAp ka, int l, bool latent, const int wv) {
    const TI t = thread_info(wv); const int gw = t.gw, NGW = t.NGW, lane = t.lane;
    const GAS float* HALO = (const GAS float*)(ka->ws + WS_HALO); bf16* ACT = (bf16*)(ka->ws + WS_ACT); const GAS float* cw = (const GAS float*)(A_FCONV(ka) + (size_t)l * 3 * NUP);
    const int ntile = latent ? 128 : NTM, nitems = ntile * 2 * 22;
    for (int it = gw; it < nitems; it += NGW) {
        const int ch = it % 22, edge = (it / 22) & 1, tv = it / 44, pm = latent ? tv + (tv >> 4) + 1 : tv, t17 = pm % 17;
        const int col = ch * 256 + lane * 4;
        const GAS float* hrow[3]; bool zero0 = false, zero2 = false;
        if (edge == 0) { zero0 = (t17 == 0 || t17 == 1); hrow[0] = HALO + ((size_t)((pm - 1) * 4 + 3) * 2) * DFF; hrow[1] = HALO + ((size_t)(pm * 4 + 0) * 2) * DFF; hrow[2] = HALO + ((size_t)(pm * 4 + 1) * 2) * DFF; }
        else { zero2 = (t17 == 0 || t17 == 16); hrow[0] = HALO + ((size_t)(pm * 4 + 2) * 2) * DFF; hrow[1] = HALO + ((size_t)(pm * 4 + 3) * 2) * DFF; hrow[2] = HALO + ((size_t)((pm + 1) * 4 + 0) * 2) * DFF; }
        f32x4 cg = (f32x4){0.f, 0.f, 0.f, 0.f}, cu = cg;
#pragma unroll
        for (int j = 0; j < 3; ++j) {
            const bool z = (j == 0 && zero0) || (j == 2 && zero2);
            if (!z) { const f32x4 g = *(const GAS f32x4*)(hrow[j] + col), u = *(const GAS f32x4*)(hrow[j] + DFF + col);
                cg += g * *(const GAS f32x4*)(cw + (size_t)j * NUP + col); cu += u * *(const GAS f32x4*)(cw + (size_t)j * NUP + DFF + col); }
        }
        f32x4 o;
#pragma unroll
        for (int e = 0; e < 4; ++e) o[e] = cg[e] * __builtin_amdgcn_rcpf(1.f + __expf(-cg[e])) * cu[e];
        v2u w; w.x = pk2(o[0], o[1]); w.y = pk2(o[2], o[3]);
        *(v2u*)(ACT + (size_t)(pm * 256 + (edge ? 255 : 0)) * DFF + col) = w;
    }
}

__device__ __forceinline__ void ph_sc_fix(KAp ka, int i, bool latent, const int wv) {
    const TI t = thread_info(wv); const int gw = t.gw, NGW = t.NGW, lane = t.lane;
    const GAS float* HALO = (const GAS float*)(ka->ws + WS_SCHALO); const bf16* BB = (const bf16*)(ka->ws + WS_BB); bf16* O = (bf16*)(ka->ws + WS_O);
    const GAS float* cw = (const GAS float*)(A_SCCONV(ka) + (size_t)i * 3 * DM);
    const int ntile = latent ? 128 : NTM, nitems = ntile * 2 * 8;
    for (int it = gw; it < nitems; it += NGW) {
        const int ch = it & 7, edge = (it >> 3) & 1, tv = it >> 4, pm = latent ? tv + (tv >> 4) + 1 : tv, t17 = pm % 17;
        const int col = ch * 256 + lane * 4, row = pm * 256 + (edge ? 255 : 0);
        const GAS float* hrow[3]; bool zero0 = false, zero2 = false;
        if (edge == 0) { zero0 = (t17 == 0 || t17 == 1); hrow[0] = HALO + (size_t)((pm - 1) * 4 + 3) * DM; hrow[1] = HALO + (size_t)(pm * 4 + 0) * DM; hrow[2] = HALO + (size_t)(pm * 4 + 1) * DM; }
        else { zero2 = (t17 == 0 || t17 == 16); hrow[0] = HALO + (size_t)(pm * 4 + 2) * DM; hrow[1] = HALO + (size_t)(pm * 4 + 3) * DM; hrow[2] = HALO + (size_t)((pm + 1) * 4 + 0) * DM; }
        f32x4 cv = (f32x4){0.f, 0.f, 0.f, 0.f};
#pragma unroll
        for (int j = 0; j < 3; ++j) { const bool z = (j == 0 && zero0) || (j == 2 && zero2);
            if (!z) cv += *(const GAS f32x4*)(hrow[j] + col) * *(const GAS f32x4*)(cw + (size_t)j * DM + col); }
        const v2u bw = *(const v2u*)(BB + (size_t)row * DM + col);
        const f32x4 o = cv * (f32x4){bflo(bw.x), bfhi(bw.x), bflo(bw.y), bfhi(bw.y)};
        v2u w; w.x = pk2(o[0], o[1]); w.y = pk2(o[2], o[3]);
        *(v2u*)(O + (size_t)row * DM + col) = w;
    }
}
__device__ __forceinline__ void ph_sc_gate(const bf16* IN, bf16* OUT, const float* cw, int ntile, bool latent, const int wv) {
    const TI t = thread_info(wv); const int gw = t.gw, NGW = t.NGW, lane = t.lane;
    const int nitems = ntile * 4 * 8;
    for (int it = gw; it < nitems; it += NGW) {
        const int seg = it & 7, cc = (it >> 3) & 3, tv = it >> 5, pm = latent ? tv + (tv >> 4) + 1 : tv;
        const int col = cc * 512 + lane * 8, R0 = pm * 256 + seg * 32;
        f32x4 w0[3], w1[3];
#pragma unroll
        for (int j = 0; j < 3; ++j) { w0[j] = *(const f32x4*)(cw + (size_t)j * DM + col); w1[j] = *(const f32x4*)(cw + (size_t)j * DM + col + 4); }
        struct Row { f32x4 p0, p1; v4u g; };
        const v4u z4 = (v4u){0u, 0u, 0u, 0u};
#define SG_LOAD(R, D) do { const bf16* rp = IN + (size_t)(R) * NSC + col; D.g = *(const v4u*)rp; const v4u a = *(const v4u*)(rp + DM), b = *(const v4u*)(rp + 2 * DM); \
            D.p0 = (f32x4){bflo(a.x) * bflo(b.x), bfhi(a.x) * bfhi(b.x), bflo(a.y) * bflo(b.y), bfhi(a.y) * bfhi(b.y)}; \
            D.p1 = (f32x4){bflo(a.z) * bflo(b.z), bfhi(a.z) * bfhi(b.z), bflo(a.w) * bflo(b.w), bfhi(a.w) * bfhi(b.w)}; } while (0)
#define SG_ZERO(D) do { D.p0 = (f32x4){0.f, 0.f, 0.f, 0.f}; D.p1 = D.p0; D.g = z4; } while (0)
        Row rp_, rc_, rn1, rn2, rn3;
        const int tt0 = R0 % TPB; const bool top = (tt0 == 0 || tt0 == CTXL), bot = ((tt0 + 31) == CTXL - 1 || (tt0 + 31) == TPB - 1);
        if (top) SG_ZERO(rp_); else SG_LOAD(R0 - 1, rp_);
        SG_LOAD(R0, rc_); SG_LOAD(R0 + 1, rn1); SG_LOAD(R0 + 2, rn2);
        for (int i = 0; i < 32; ++i) {
            if (i + 3 < 32 || (i + 3 == 32 && !bot)) SG_LOAD(R0 + i + 3, rn3); else SG_ZERO(rn3);
            f32x4 o0 = rp_.p0 * w0[0] + rc_.p0 * w0[1] + rn1.p0 * w0[2], o1 = rp_.p1 * w1[0] + rc_.p1 * w1[1] + rn1.p1 * w1[2];
            const v4u g = rc_.g;
            o0 = o0 * (f32x4){bflo(g.x), bfhi(g.x), bflo(g.y), bfhi(g.y)}; o1 = o1 * (f32x4){bflo(g.z), bfhi(g.z), bflo(g.w), bfhi(g.w)};
            v4u ov; ov.x = pk2(o0[0], o0[1]); ov.y = pk2(o0[2], o0[3]); ov.z = pk2(o1[0], o1[1]); ov.w = pk2(o1[2], o1[3]);
            *(v4u*)(OUT + (size_t)(R0 + i) * DM + col) = ov;
            rp_ = rc_; rc_ = rn1; rn1 = rn2; rn2 = rn3;
        }
#undef SG_LOAD
#undef SG_ZERO
    }
}

__global__ void __launch_bounds__(NWAVES * 64, 2) __attribute__((amdgpu_flat_work_group_size(NWAVES * 64, NWAVES * 64))) dit_fwd(Args args_by_kernarg) {
    extern __shared__ __attribute__((aligned(16))) unsigned char lds[];
    LAS unsigned char* ldsl = (LAS unsigned char*)lds;
    (void)args_by_kernarg;
    for (int u = threadIdx.x; u < (LDS_BYTES - LDSCTL_OFF) / 4; u += NWAVES * 64) ((LAS unsigned*)(ldsl + LDSCTL_OFF))[u] = 0u;
    __syncthreads();
#if MK_ONE_LAUNCH
    XcdBarrier bar = xcd_barrier_post((unsigned*)(kargs()->ws + WS_CTL) + CW_BAR, (volatile LAS unsigned*)(ldsl + MISC_OFF) + 8);
#define GRID_BAR() do { XcdBarrier b2_ = bar; asm volatile("" : "+s"(b2_.bar)); int w0_ = wave0; asm volatile("" : "+s"(w0_)); xcd_barrier(b2_, w0_ == 0 && pg8::lane_id_l() == 0); } while (0)
#else
#define GRID_BAR() do { } while (0)
#endif
    const int wave0 = __builtin_amdgcn_readfirstlane((int)threadIdx.x >> 6);
    const int lo = kargs()->ph_lo, hi = kargs()->ph_hi;
    int ph = 0;
#define PH_BEGIN if (ph >= lo && ph < hi) { const KAp ka = kargs(); unsigned char* const ws = ka->ws; int L = l; asm volatile("" : "+s"(L)); int HF = half; asm volatile("" : "+s"(HF)); int WV = wave0; asm volatile("" : "+s"(WV)); (void)L; (void)HF; (void)ws;
#define PH_END } if (ph >= lo && ph + 1 < hi) { GRID_BAR(); } ++ph;
#define GEMM_RUN(EPI) pg8::gemm_phase<EPI, pg8::Order, true, true>(ldsl + RING_OFF, g, S, E, WV)

    { const int l = 0, half = 0;
      PH_BEGIN ph_prologue(ka, ldsl, WV); PH_END
      PH_BEGIN ph_modfin(ka, WV); PH_END
      PH_BEGIN {
          const TI t = thread_info(WV);
          pg8::Gemm g{(const bf16*)(ws + WS_SHIFT), (const bf16*)(ws + WS_W), 256, pg8::SB_LD, DM}; pg8::OrderSB S; S.init(0, t.bx, t.G);
          pg8::EpiSB E{(float*)(ws + WS_SB)};
          pg8::gemm_phase<pg8::EpiSB, pg8::OrderSB, true, true>(ldsl + RING_OFF, g, S, E, WV);
          ph_xinit(ka, WV, 2 * pg8::NSBT_UP + pg8::NSBT_IN + pg8::NSBT_SC < t.G ? 2 * pg8::NSBT_UP + pg8::NSBT_IN + pg8::NSBT_SC : t.G); } PH_END }

    for (int l = 0; l < 4; ++l) {
        const int half = 0;
        if (!(l & 1)) {
            PH_BEGIN {
                const TI t = thread_info(WV); const int i = L >> 1;
                pg8::Gemm g{(const bf16*)(ws + WS_H), (const bf16*)(ws + WS_W_IN + i * W_IN_SZ), MR, NPROJP, DM}; pg8::Order S; S.init(NTM, NPROJP / 256, t.G, t.bx, 0, 0);
                pg8::EpiStoreBf16N<NPROJP> E{(bf16*)(ws + WS_PROJ), (const float*)(ws + WS_SS), (const float*)(ws + WS_SB) + (size_t)((L * 2 + 0) * 9) * pg8::SB_LD + SB_COL_IN + i * NPROJP, (LAS float*)(ldsl + XTRA_OFF + 9216)};
                GEMM_RUN(pg8::EpiStoreBf16N<NPROJP>); } PH_END
            PH_BEGIN ph_attn_post(ka, L >> 1, WV); PH_END
            PH_BEGIN {
                const TI t = thread_info(WV); const int i = L >> 1;
                { pg8::Gemm g{(const bf16*)(ws + WS_CQ), (const bf16*)(ws + WS_W_UQ + i * W_UQ_SZ), MR, NQB, 512}; pg8::Order S; S.init(L == 0 ? NTM : 128, NQB / 256, t.G, t.bx, L == 0 ? 0 : 1, 0);
                  pg8::EpiStoreBf16<NQB> E{(bf16*)(ws + WS_QB)};
                  GEMM_RUN(pg8::EpiStoreBf16<NQB>); }
                { pg8::Gemm g{(const bf16*)(ws + WS_CKV), (const bf16*)(ws + WS_W_UKV + i * W_UKV_SZ), MR, NKVB, 256}; const int rot = ((((L == 0 ? NTM : 128) * (NQB / 256)) % t.G) / 8) * 8;
                  pg8::Order S; S.init(NTM, NKVB / 256, t.G, (t.bx + t.G - rot) % t.G, 0, 0);
                  pg8::EpiStoreBf16<NKVB> E{(bf16*)(ws + WS_KVB)};
                  GEMM_RUN(pg8::EpiStoreBf16<NKVB>); } } PH_END
            PH_BEGIN { {
                const TI t = thread_info(WV);
                const bf16* QA = (const bf16*)(ws + WS_QA); const bf16* KA = (const bf16*)(ws + WS_KA); const bf16* PROJ = (const bf16*)(ws + WS_PROJ); bf16* OB = (bf16*)(ws + WS_O);
                const int nA = (L == 0) ? 1280 : 1024;
                for (int a = t.vcu; a < nA; a += t.G) {
                    int b, h, qrow0, seq;
                    if (a < 1024) { const int ii = a >> 8, xx = (a >> 5) & 7, j = a & 31; b = xx; h = 2 * ii + (j >> 4); qrow0 = b * TPB + CTXL + (j & 15) * 256; seq = TPB; }
                    else { const int xx = (a - 1024) >> 5, j = (a - 1024) & 31; if (j >= 8) continue; b = xx; h = j; qrow0 = b * TPB; seq = CTXL; }
                    const size_t kv0 = (size_t)b * TPB;
                    att::attn_unit<128, 2, NPROJP, 256, NPROJP, DM>(PROJ + (size_t)qrow0 * NPROJP + h * 128, KA + kv0 * 256 + (h >> 2) * 128, nullptr,
                                           PROJ + kv0 * NPROJP + 1280 + (h >> 2) * 128, OB + (size_t)qrow0 * DM + h * 128, seq, 0.08838834764831845f, (char*)lds, WV, (const float*)(ws + WS_TAB), a < 1024 ? (a & 15) * 256 : -1,
                                           A_QNORM(ka) + (L >> 1) * 128);
                } }
              {
                const TI t = thread_info(WV);
                const bf16* QB = (const bf16*)(ws + WS_QB); const bf16* KVB = (const bf16*)(ws + WS_KVB); const bf16* KR = (const bf16*)(ws + WS_KR); bf16* OB = (bf16*)(ws + WS_O);
                const int nA = (L == 0) ? 1280 : 1024;
                for (int a = t.vcu; a < nA; a += t.G) {
                    int b, h, qrow0, seq;
                    const int j_ = a & 31;
                    if (a < 1024) { const int ii = a >> 8, xx = (a >> 5) & 7, j = a & 31; b = xx; h = 2 * ii + (j >> 4); qrow0 = b * TPB + CTXL + (j & 15) * 256; seq = TPB; }
                    else { const int xx = (a - 1024) >> 5, j = (a - 1024) & 31; if (j < 8 || j >= 16) continue; b = xx; h = j - 8; qrow0 = b * TPB; seq = CTXL; }
                    const size_t kv0 = (size_t)b * TPB;
                    att::attn_unit<192, 1, NQB, NKVB, NKVB, DM>(QB + (size_t)qrow0 * NQB + h * 192, KVB + kv0 * NKVB + h * 256, KR + kv0 * 64,
                                           KVB + kv0 * NKVB + h * 256 + 128, OB + (size_t)qrow0 * DM + 1024 + h * 128, seq, 0.07216878364870323f, (char*)lds, WV, (const float*)(ws + WS_TAB + 16384), a < 1024 ? (j_ & 15) * 256 : -1, nullptr);
                } } } PH_END
            PH_BEGIN {
                const TI t = thread_info(WV); const int i = L >> 1;
                pg8::Gemm g{(const bf16*)(ws + WS_O), (const bf16*)(ws + WS_W_O + i * W_O_SZ), MR, DM, DM}; pg8::OrderSplit S; S.init(DM / 256, t.G, t.bx, DM / 64, L == 0 ? 8 : 0);
                pg8::EpiResidNorm E{(bf16*)(ws + WS_X), (const float*)(ws + WS_MOD) + (size_t)L * 9 * MODW + 2 * DM, (bf16*)(ws + WS_H), (const float*)(ws + WS_WEFF) + (size_t)((L * 2 + 1) * 9) * DM,
                                    (float*)(ws + WS_SS), (LAS float*)(ldsl + XTRA_OFF), 1, (float*)(ws + WS_SLAB), DM / 64, (LAS float*)(ldsl + XTRA_OFF + 9216)};
                pg8::gemm_phase<pg8::EpiResidNorm, pg8::OrderSplit, true, true>(ldsl + RING_OFF, g, S, E, WV); } PH_END
            if (l == 0) { PH_BEGIN ph_ctx_combine(ka, (const float*)(ws + WS_MOD) + ((size_t)L * 9 + 8) * MODW + 2 * DM, (const float*)(ws + WS_WEFF) + (size_t)((L * 2 + 1) * 9 + 8) * DM, true, WV); PH_END }
        } else {
            PH_BEGIN {
                const TI t = thread_info(WV); const int i = L >> 1; const bool ctxl = L < 2;
                pg8::Gemm g{(const bf16*)(ws + WS_H), (const bf16*)(ws + WS_W_SCIN + i * W_SCIN_SZ), MR, NSC, DM}; pg8::OrderSc S; S.init(ctxl ? NTM : 128, t.G, t.bx, ctxl ? 0 : 1);
                pg8::EpiScIn E{(bf16*)(ws + WS_BB), (bf16*)(ws + WS_O), (float*)(ws + WS_SCHALO), A_SCCONV(ka) + (size_t)i * 3 * DM, (LAS float*)(ldsl + XTRA_OFF),
                               (const float*)(ws + WS_SS), (const float*)(ws + WS_SB) + (size_t)((L * 2 + 0) * 9) * pg8::SB_LD + SB_COL_SCIN + i * NSC, (LAS float*)(ldsl + XTRA_OFF + 9216)};
                pg8::gemm_phase<pg8::EpiScIn, pg8::OrderSc, true, true>(ldsl + RING_OFF, g, S, E, WV);
                if (L == 1) { const TI t2 = thread_info(WV); const int nheavy = (NTM * 8) % t2.G; if (t2.bx >= nheavy) { ph_late_tr(ka, ldsl, WV, t2.bx - nheavy, t2.G - nheavy);
                        __syncthreads();
                        pg8::Gemm g2{(const bf16*)(ka->ws + WS_SHIFT), (const bf16*)(ka->ws + WS_W), 256, pg8::SB_LD, DM}; pg8::OrderSB S2; S2.init(1, t2.bx - nheavy, t2.G - nheavy);
                        pg8::EpiSB E2{(float*)(ka->ws + WS_SB)}; pg8::gemm_phase<pg8::EpiSB, pg8::OrderSB, true, true>(ldsl + RING_OFF, g2, S2, E2, WV); } } } PH_END
            PH_BEGIN ph_sc_fix(ka, L >> 1, L >= 2, WV); PH_END
            PH_BEGIN {
                const TI t = thread_info(WV); const int i = L >> 1;
                pg8::Gemm g{(const bf16*)(ws + WS_O), (const bf16*)(ws + WS_W_SCOUT + i * W_SCOUT_SZ), MR, DM, DM}; pg8::OrderSplit S; S.init(DM / 256, t.G, t.bx, DM / 64, L < 2 ? 8 : 0);
                pg8::EpiResidNorm E{(bf16*)(ws + WS_X), (const float*)(ws + WS_MOD) + (size_t)L * 9 * MODW + 2 * DM, (bf16*)(ws + WS_H), (const float*)(ws + WS_WEFF) + (size_t)((L * 2 + 1) * 9) * DM,
                                    (float*)(ws + WS_SS), (LAS float*)(ldsl + XTRA_OFF), 1, (float*)(ws + WS_SLAB), DM / 64, (LAS float*)(ldsl + XTRA_OFF + 9216)};
                pg8::gemm_phase<pg8::EpiResidNorm, pg8::OrderSplit, true, true>(ldsl + RING_OFF, g, S, E, WV); } PH_END
            if (l == 1) { PH_BEGIN ph_ctx_combine(ka, (const float*)(ws + WS_MOD) + ((size_t)L * 9 + 8) * MODW + 2 * DM, (const float*)(ws + WS_WEFF) + (size_t)((L * 2 + 1) * 9 + 8) * DM, true, WV); PH_END }
        }
        PH_BEGIN {
                const TI t = thread_info(WV); const bool ctxl = L < 2;
                pg8::Gemm g{(const bf16*)(ws + WS_H), (const bf16*)(ws + WS_W_UP + L * W_UP_SZ), MR, NUP, DM}; pg8::Order S; S.init(ctxl ? NTM : 128, NUP / 256, t.G, t.bx, ctxl ? 0 : 1, 0);
                pg8::EpiConvGate E{(bf16*)(ws + WS_ACT), (float*)(ws + WS_HALO), A_FCONV(ka) + (size_t)L * 3 * NUP, (LAS float*)(ldsl + XTRA_OFF),
                                   (const float*)(ws + WS_SS), (const float*)(ws + WS_SB) + (size_t)((L * 2 + 1) * 9) * pg8::SB_LD + SB_COL_UP + L * NUP, (LAS float*)(ldsl + XTRA_OFF + 9216)};
                GEMM_RUN(pg8::EpiConvGate);
                if (L < 2) { const TI t2 = thread_info(WV); const int nheavy = (NTM * (NUP / 256)) % t2.G; if (t2.bx >= nheavy) ph_dn0_tr(ka, ldsl, WV, t2.bx - nheavy, t2.G - nheavy, L); } } PH_END
        PH_BEGIN ph_ffn_fix(ka, L, L >= 2, WV); PH_END
        PH_BEGIN {
                const TI t = thread_info(WV); const int ln = L < 3 ? L + 1 : 3;
                pg8::Gemm g{(const bf16*)(ws + WS_ACT), (const bf16*)(ws + WS_W_DN + L * W_DN_SZ), MR, DM, DFF}; pg8::OrderSplit S; S.init(DM / 256, t.G, t.bx, DFF / 64, L < 2 ? 8 : 0);
                pg8::EpiResidNorm E{(bf16*)(ws + WS_X), (const float*)(ws + WS_MOD) + (size_t)L * 9 * MODW + 5 * DM, (bf16*)(ws + WS_H), (const float*)(ws + WS_WEFF) + (size_t)((ln * 2 + 0) * 9) * DM,
                                    (float*)(ws + WS_SS), (LAS float*)(ldsl + XTRA_OFF), L < 3 ? 1 : 0, (float*)(ws + WS_SLAB), DFF / 64, (LAS float*)(ldsl + XTRA_OFF + 9216)};
                pg8::gemm_phase<pg8::EpiResidNorm, pg8::OrderSplit, true, true>(ldsl + RING_OFF, g, S, E, WV); } PH_END
        if (l < 2) { PH_BEGIN ph_ctx_combine(ka, (const float*)(ws + WS_MOD) + ((size_t)L * 9 + 8) * MODW + 5 * DM, (const float*)(ws + WS_WEFF) + (size_t)(((L + 1) * 2 + 0) * 9 + 8) * DM, true, WV); PH_END }
    }
    { const int l = 0, half = 0;
      PH_BEGIN ph_final(ka, WV); PH_END }
#undef PH_BEGIN
#undef PH_END
#undef GEMM_RUN
}

extern "C" void kernel_launch(void* const* d_in, const int* in_sizes, int n_in, void* d_out, int out_size, void* d_ws, size_t ws_size, hipStream_t stream) {
    static int grid = 0;
    if (grid == 0) {
        if (n_in != 23 || in_sizes[0] != NB * SEQ * DM || out_size != NB * SEQ * DM || ws_size < WS_END) {
            fprintf(stderr, "kernel_launch: built for 23 inputs, x/out of %d floats, >= %zu bytes of workspace; got n_in %d, in0 %d, out %d, ws %zu; nothing launched\n",
                    NB * SEQ * DM, (size_t)WS_END, n_in, n_in > 0 ? in_sizes[0] : -1, out_size, ws_size); grid = -1; return; }
        int dev = 0, cus = 0, per_cu = 0;
        if (hipGetDevice(&dev) != hipSuccess || hipDeviceGetAttribute(&cus, hipDeviceAttributeMultiprocessorCount, dev) != hipSuccess) { fprintf(stderr, "kernel_launch: device query failed\n"); grid = -1; return; }
        if (hipFuncSetAttribute((const void*)dit_fwd, hipFuncAttributeMaxDynamicSharedMemorySize, LDS_BYTES) != hipSuccess) { fprintf(stderr, "kernel_launch: hipFuncSetAttribute(%d B LDS) failed\n", LDS_BYTES); grid = -1; return; }
        if (hipOccupancyMaxActiveBlocksPerMultiprocessor(&per_cu, (const void*)dit_fwd, NWAVES * 64, LDS_BYTES) != hipSuccess || per_cu < 1)
            fprintf(stderr, "kernel_launch: note: occupancy query reports %d workgroups per CU\n", per_cu);
        (void)hipGetLastError();
        grid = cus;
    }
    if (grid < 0) return;
    if (hipMemsetAsync((char*)d_ws + WS_CTL, 0, CTL_ZERO_BYTES, stream) != hipSuccess) { fprintf(stderr, "kernel_launch: hipMemsetAsync failed\n"); return; }
    Args a{};
    for (int i = 0; i < 23; ++i) a.in[i] = (const float*)d_in[i];
    a.out = (float*)d_out; a.ws = (unsigned char*)d_ws;
#if MK_ONE_LAUNCH
    a.ph_lo = 0; a.ph_hi = NPH;
    hipLaunchKernelGGL(dit_fwd, dim3(grid), dim3(NWAVES * 64), LDS_BYTES, stream, a);
#else
    for (int p = 0; p < NPH; ++p) { a.ph_lo = p; a.ph_hi = p + 1; hipLaunchKernelGGL(dit_fwd, dim3(grid), dim3(NWAVES * 64), LDS_BYTES, stream, a); }
#endif
    const hipError_t le = hipPeekAtLastError();
    if (le != hipSuccess) fprintf(stderr, "kernel_launch: launch failed: %s (grid %d)\n", hipGetErrorName(le), grid);
}
```
